# Optimizing an MI355X kernel written in HIP

```python
import math
import jax, jax.numpy as jnp
from jax import lax
import numpy as np

D_MODEL = 1024
BATCH = 2
SEQ = 8192
DEPTH = 4
DEC_BATCH = 32
DEC_SEQ = 4
PAST_LEN = 8192
PAGE_SIZE = 128

CONV_DIM = D_MODEL // 4
ATT_HEADS = 4
ATT_HDIM = D_MODEL // 16
ATT_DIM = ATT_HEADS * ATT_HDIM
HG_HEADS = 4
HG_DIM = D_MODEL - CONV_DIM - ATT_DIM
HG_KDIM = HG_DIM // HG_HEADS
HG_VDIM = HG_DIM // HG_HEADS
HG_CHUNK = 64
CONV_WIDTH = 31
DILATED_BRANCHES = ((128, 1), (512, 4), (2048, 16))
ATT_MAX_WIN = 2048
FFN_DIM = ((8 * D_MODEL // 3 + 255) // 256) * 256
EPS = 1e-6
NEG_BIG = -1e30
N_IN = 2 * CONV_DIM + 3 * ATT_DIM + 4 * HG_DIM
SPLITS = (2 * CONV_DIM,
          2 * CONV_DIM + ATT_DIM,
          2 * CONV_DIM + 2 * ATT_DIM,
          2 * CONV_DIM + 3 * ATT_DIM,
          2 * CONV_DIM + 3 * ATT_DIM + HG_DIM,
          2 * CONV_DIM + 3 * ATT_DIM + 2 * HG_DIM,
          2 * CONV_DIM + 3 * ATT_DIM + 3 * HG_DIM)

kernel_name = "hymba_conv_dilatedattn_hgrn2_decode_step"

F32 = jnp.float32


def _rmsnorm(x, g):
    x32 = x.astype(F32)
    y = x32 * lax.rsqrt(jnp.mean(x32 * x32, axis=-1, keepdims=True) + EPS)
    return (y * g.astype(F32)).astype(x.dtype)


def _layernorm(x, g, b):
    x32 = x.astype(F32)
    xc = x32 - jnp.mean(x32, axis=-1, keepdims=True)
    y = xc * lax.rsqrt(jnp.mean(xc * xc, axis=-1, keepdims=True) + EPS)
    return (y * g.astype(F32) + b.astype(F32)).astype(x.dtype)


def _swiglu(h, w_gate, w_up, w_down):
    return (jax.nn.silu(h @ w_gate) * (h @ w_up)) @ w_down


def _alibi_slopes():
    return jnp.asarray([2.0 ** (-8.0 * (h + 1) / ATT_HEADS) for h in range(ATT_HEADS)], dtype=F32)


def _conv_group(z, conv_state, dw_w, dw_b, ln_g, ln_b):
    a, gate = jnp.split(z, 2, axis=-1)
    u = a * jax.nn.sigmoid(gate)
    full = jnp.concatenate([conv_state.astype(u.dtype), u], axis=1)
    y = lax.conv_general_dilated(full, dw_w[:, None, :].astype(u.dtype), window_strides=(1,),
                                 padding="VALID", dimension_numbers=("NWC", "WIO", "NWC"),
                                 feature_group_count=CONV_DIM)
    y = jax.nn.silu(_layernorm(y + dw_b, ln_g, ln_b))
    return y, full[:, -(CONV_WIDTH - 1):]


def _dilated_branch_prompt(q, k, v, window, dil, slopes):
    B, S, H, Dh = q.shape
    blk = window // dil
    span = window
    Sp = -(-S // span) * span
    nb = Sp // span

    def to_blocks(t):
        t = jnp.pad(t.astype(F32), ((0, 0), (0, Sp - S), (0, 0), (0, 0)))
        t = t.reshape(B, Sp // dil, dil, H, Dh).transpose(0, 2, 3, 1, 4)
        return t.reshape(B, dil, H, nb, blk, Dh)

    def with_prev(t):
        prev = jnp.pad(t, ((0, 0), (0, 0), (0, 0), (1, 0), (0, 0), (0, 0)))[:, :, :, :-1]
        return jnp.concatenate([prev, t], axis=4)

    qb = to_blocks(q)
    kk = with_prev(to_blocks(k))
    vv = with_prev(to_blocks(v))
    s = jnp.einsum("brhnqd,brhnkd->brhnqk", qb, kk)
    qi = jnp.arange(blk)[:, None]
    ki = jnp.arange(2 * blk)[None, :]
    j = qi - ki + blk
    n = jnp.arange(nb)[:, None, None]
    valid = (j >= 0) & (j <= blk) & ((n > 0) | (ki >= blk))
    bias = -slopes[:, None, None, None] * (j * dil).astype(F32)
    s = jnp.where(valid, s + bias, NEG_BIG)
    m = jnp.max(s, axis=-1, keepdims=True)
    p = jnp.exp(s - m)
    l = jnp.sum(p, axis=-1)
    o = jnp.einsum("brhnqk,brhnkd->brhnqd", p, vv) / l[..., None]
    lse = m[..., 0] + jnp.log(l)
    o = o.reshape(B, dil, H, Sp // dil, Dh).transpose(0, 3, 1, 2, 4).reshape(B, Sp, H, Dh)[:, :S]
    lse = lse.reshape(B, dil, H, Sp // dil).transpose(0, 3, 1, 2).reshape(B, Sp, H)[:, :S]
    return o, lse


def _dilated_branch_sample(q, kf, vf, n_past, window, dil, slopes):
    T = q.shape[1]
    jj = jnp.arange(window // dil + 1)
    idx = n_past + jnp.arange(T)[:, None] - jj[None, :] * dil
    valid = idx >= 0
    idx = jnp.maximum(idx, 0)
    kg = kf[:, idx].astype(F32)
    vg = vf[:, idx].astype(F32)
    s = jnp.einsum("bthd,btjhd->bthj", q, kg)
    bias = -slopes[:, None] * (jj * dil).astype(F32)
    s = jnp.where(valid[:, None, :], s + bias, NEG_BIG)
    m = jnp.max(s, axis=-1, keepdims=True)
    p = jnp.exp(s - m)
    l = jnp.sum(p, axis=-1)
    o = jnp.einsum("bthj,btjhd->bthd", p, vg) / l[..., None]
    lse = m[..., 0] + jnp.log(l)
    return o, lse


def _att_group(q, k, v, k_buf, v_buf, slopes):
    qs = q.astype(F32) * (ATT_HDIM ** -0.5)
    outs, lses = [], []
    if k_buf is None:
        for window, dil in DILATED_BRANCHES:
            o, lse = _dilated_branch_prompt(qs, k, v, window, dil, slopes)
            outs.append(o)
            lses.append(lse)
    else:
        kf = jnp.concatenate([k_buf.astype(k.dtype), k], axis=1)
        vf = jnp.concatenate([v_buf.astype(v.dtype), v], axis=1)
        n_past = k_buf.shape[1]
        for window, dil in DILATED_BRANCHES:
            o, lse = _dilated_branch_sample(qs, kf, vf, n_past, window, dil, slopes)
            outs.append(o)
            lses.append(lse)
    w = jax.nn.softmax(jnp.stack(lses, axis=0), axis=0)
    o = jnp.sum(w[..., None] * jnp.stack(outs, axis=0), axis=0)
    return o.astype(q.dtype)


def _gated_recurrence(q, k, v, logf, s0, chunk):
    B, T, H, dk = q.shape
    dv = v.shape[-1]
    nc = T // chunk

    def to_chunks(t):
        return t.reshape(B, nc, chunk, H, t.shape[-1]).transpose(1, 0, 3, 2, 4)

    causal = jnp.tril(jnp.ones((chunk, chunk), dtype=bool))

    def step(S, inp):
        qc, kc, vc, gc = inp
        b = jnp.cumsum(gc, axis=2)
        diff = b[:, :, :, None, :] - b[:, :, None, :, :]
        decay = jnp.exp(jnp.where(causal[:, :, None], diff, NEG_BIG))
        a = jnp.einsum("bhtd,bhsd,bhtsd->bhts", qc, kc, decay)
        o = jnp.einsum("bhts,bhsv->bhtv", a, vc) + jnp.einsum("bhtd,bhdv->bhtv", qc * jnp.exp(b), S)
        b_last = b[:, :, -1:, :]
        S = jnp.exp(b_last[:, :, 0, :])[..., None] * S + jnp.einsum(
            "bhsd,bhsv->bhdv", kc * jnp.exp(b_last - b), vc)
        return S, o

    s_fin, o = lax.scan(step, s0, (to_chunks(q), to_chunks(k), to_chunks(v), to_chunks(logf)))
    return o.transpose(1, 0, 3, 2, 4).reshape(B, T, H, dv), s_fin


def _hgrn2_group(zq, zf, zi, zg, s0, lb, norm_g):
    B, T, _ = zq.shape
    q = jax.nn.silu(zq.astype(F32)).reshape(B, T, HG_HEADS, HG_KDIM)
    lbv = lb.astype(F32)
    f = lbv + (1.0 - lbv) * jax.nn.sigmoid(zf.astype(F32))
    logf = jnp.log(f).reshape(B, T, HG_HEADS, HG_KDIM)
    k = (1.0 - f).reshape(B, T, HG_HEADS, HG_KDIM)
    v = zi.astype(F32).reshape(B, T, HG_HEADS, HG_VDIM)
    chunk = HG_CHUNK if T % HG_CHUNK == 0 else T
    o, s_fin = _gated_recurrence(q, k, v, logf, s0.astype(F32), chunk)
    o = _rmsnorm(o, norm_g) * jax.nn.silu(zg.astype(F32)).reshape(B, T, HG_HEADS, HG_VDIM)
    return o.reshape(B, T, HG_DIM).astype(zq.dtype), s_fin


def _layer(x, conv_state, k_buf, v_buf, hg_state, lb, slopes,
           ln1, wg1, wu1, wd1, lnm, wi, dww, dwb, clg, clb, hgn, wo, ln2, wg2, wu2, wd2):
    B, T, _ = x.shape
    x = x + 0.5 * _swiglu(_rmsnorm(x, ln1), wg1, wu1, wd1)
    z = _rmsnorm(x, lnm) @ wi
    z_conv, zq, zk, zv, hq, hf, hi, hg = jnp.split(z, SPLITS, axis=-1)
    y_conv, conv_new = _conv_group(z_conv, conv_state, dww, dwb, clg, clb)
    q = zq.reshape(B, T, ATT_HEADS, ATT_HDIM)
    k = zk.reshape(B, T, ATT_HEADS, ATT_HDIM)
    v = zv.reshape(B, T, ATT_HEADS, ATT_HDIM)
    y_att = _att_group(q, k, v, k_buf, v_buf, slopes).reshape(B, T, ATT_DIM)
    y_hg, hg_new = _hgrn2_group(hq, hf, hi, hg, hg_state, lb, hgn)
    x = x + jnp.concatenate([y_conv, y_att, y_hg], axis=-1) @ wo
    x = x + 0.5 * _swiglu(_rmsnorm(x, ln2), wg2, wu2, wd2)
    if k_buf is None:
        keep = min(ATT_MAX_WIN, T)
        k_new, v_new = k[:, -keep:], v[:, -keep:]
    else:
        k_new, v_new = k, v
    return x, conv_new, k_new, v_new, hg_new.astype(x.dtype)


def setup_inputs(seed: int = 0) -> dict:
    key = jax.random.key(seed)
    ks = jax.random.split(key, 32)
    d = D_MODEL
    win = min(ATT_MAX_WIN, PAST_LEN)

    def nrm(k, shape, scale):
        return scale * jax.random.normal(k, shape, F32)

    return {
        "x_prompt": nrm(ks[0], (BATCH, SEQ, d), 1.0),
        "x_sample": nrm(ks[1], (DEC_BATCH, DEC_SEQ, d), 1.0),
        "state_conv": nrm(ks[2], (DEPTH, DEC_BATCH, CONV_WIDTH - 1, CONV_DIM), 0.5),
        "cache_k_win": nrm(ks[3], (DEPTH, DEC_BATCH, win, ATT_HEADS, ATT_HDIM), 1.0),
        "cache_v_win": nrm(ks[4], (DEPTH, DEC_BATCH, win, ATT_HEADS, ATT_HDIM), 1.0),
        "state_hgrn": nrm(ks[5], (DEPTH, DEC_BATCH, HG_HEADS, HG_KDIM, HG_VDIM), 0.5),
        "ln_ffn1": 1.0 + nrm(ks[6], (DEPTH, d), 0.01),
        "w_ffn1_gate": nrm(ks[7], (DEPTH, d, FFN_DIM), d ** -0.5),
        "w_ffn1_up": nrm(ks[8], (DEPTH, d, FFN_DIM), d ** -0.5),
        "w_ffn1_down": nrm(ks[9], (DEPTH, FFN_DIM, d), FFN_DIM ** -0.5),
        "ln_mix": 1.0 + nrm(ks[10], (DEPTH, d), 0.01),
        "w_in": nrm(ks[11], (DEPTH, d, N_IN), d ** -0.5),
        "conv_dw_w": nrm(ks[12], (DEPTH, CONV_WIDTH, CONV_DIM), CONV_WIDTH ** -0.5),
        "conv_dw_b": nrm(ks[13], (DEPTH, CONV_DIM), 0.01),
        "conv_ln_g": 1.0 + nrm(ks[14], (DEPTH, CONV_DIM), 0.01),
        "conv_ln_b": nrm(ks[15], (DEPTH, CONV_DIM), 0.01),
        "hg_lower_bounds": nrm(ks[16], (DEPTH, HG_DIM), 0.1),
        "hg_norm_g": 1.0 + nrm(ks[17], (DEPTH, HG_VDIM), 0.01),
        "w_out": nrm(ks[18], (DEPTH, d, d), d ** -0.5),
        "ln_ffn2": 1.0 + nrm(ks[19], (DEPTH, d), 0.01),
        "w_ffn2_gate": nrm(ks[20], (DEPTH, d, FFN_DIM), d ** -0.5),
        "w_ffn2_up": nrm(ks[21], (DEPTH, d, FFN_DIM), d ** -0.5),
        "w_ffn2_down": nrm(ks[22], (DEPTH, FFN_DIM, d), FFN_DIM ** -0.5),
        "ln_final": 1.0 + nrm(ks[23], (d,), 0.01),
    }


def reference(x_prompt, x_sample, state_conv, cache_k_win, cache_v_win, state_hgrn,
              ln_ffn1, w_ffn1_gate, w_ffn1_up, w_ffn1_down,
              ln_mix, w_in, conv_dw_w, conv_dw_b, conv_ln_g, conv_ln_b,
              hg_lower_bounds, hg_norm_g, w_out,
              ln_ffn2, w_ffn2_gate, w_ffn2_up, w_ffn2_down, ln_final):
    slopes = _alibi_slopes()
    sm = jax.nn.softmax(hg_lower_bounds.astype(F32), axis=0)
    lower = jnp.cumsum(sm, axis=0) - sm[0]
    Bp = x_prompt.shape[0]
    hp, hs = x_prompt, x_sample
    cp_l, cs_l, kp_l, vp_l, ks_l, vs_l, sp_l, ss_l = [], [], [], [], [], [], [], []
    for l in range(DEPTH):
        wl = (ln_ffn1[l], w_ffn1_gate[l], w_ffn1_up[l], w_ffn1_down[l],
              ln_mix[l], w_in[l], conv_dw_w[l], conv_dw_b[l], conv_ln_g[l], conv_ln_b[l],
              hg_norm_g[l], w_out[l], ln_ffn2[l], w_ffn2_gate[l], w_ffn2_up[l], w_ffn2_down[l])
        conv0 = jnp.zeros((Bp, CONV_WIDTH - 1, CONV_DIM), hp.dtype)
        hg0 = jnp.zeros((Bp, HG_HEADS, HG_KDIM, HG_VDIM), F32)
        hp, cp, kp, vp, sp = _layer(hp, conv0, None, None, hg0, lower[l], slopes, *wl)
        hs, cs, ksn, vsn, ss = _layer(hs, state_conv[l], cache_k_win[l], cache_v_win[l],
                                      state_hgrn[l], lower[l], slopes, *wl)
        cp_l.append(cp); cs_l.append(cs); kp_l.append(kp); vp_l.append(vp)
        ks_l.append(ksn); vs_l.append(vsn); sp_l.append(sp); ss_l.append(ss)
    y_prompt = _rmsnorm(hp, ln_final)
    y_sample = _rmsnorm(hs, ln_final)
    return (y_prompt, y_sample,
            jnp.stack(cp_l), jnp.stack(cs_l),
            jnp.stack(kp_l), jnp.stack(vp_l),
            jnp.stack(ks_l), jnp.stack(vs_l),
            jnp.stack(sp_l), jnp.stack(ss_l))
```

```cpp
#include <hip/hip_runtime.h>
#include <hip/hip_cooperative_groups.h>
#include <cstdio>
#include <cstdint>
namespace cg = cooperative_groups;
namespace pg8 {
#define PG8_LAS __attribute__((address_space(3)))
typedef unsigned short bf16_t;
typedef short bf16x8 __attribute__((ext_vector_type(8)));
typedef float f32x4 __attribute__((ext_vector_type(4)));
typedef unsigned u32x4 __attribute__((ext_vector_type(4)));
constexpr int BM = 256, BK = 64, HALF = 128, HTB = HALF * BK * 2  , STAGE_BYTES = 8 * HTB, NXCD = 8, WGM = 8;

__host__ __device__ __forceinline__ int lds_byte(int r, int c) { const int st = (r >> 4) * 2 + (c >> 5), rr = r & 15, cc = c & 31, ob = rr * 64 + cc * 2; return st * 1024 + (ob ^ (((ob >> 9) & 1) << 5)); }
__host__ __device__ __forceinline__ void stage_rc(int b, int& R, int& C) { const int st = b / 1024, sb = b % 1024, swz = sb ^ (((sb >> 9) & 1) << 5); R = (st >> 1) * 16 + swz / 64; C = (st & 1) * 32 + (swz % 64) / 2; }
__host__ __device__ __forceinline__ int perm32(int rho) { const int n = rho >> 4, i = rho & 15; return 8 * (i >> 2) + 4 * n + (i & 3); }

struct Unit { int pm, pn; };
struct Gemm { const bf16_t* A; const bf16_t* Bt; int M, N, K; };

struct StaticOrder {
    int nM, nN, nwg, G, c;
    __host__ __device__ void init(int M, int N, int G_, int c_) { nM = M / BM; nN = N / BM; nwg = nM * nN; G = G_; c = c_; }
    __host__ __device__ bool next(int i, Unit& u) const {
        const long L = (long)i * G + c; if (L >= nwg) return false;
        int wgid = (int)L; { const int q = nwg / NXCD, r = nwg % NXCD, xcd = wgid % NXCD, off = wgid / NXCD; wgid = (xcd < r ? xcd * (q + 1) : r * (q + 1) + (xcd - r) * q) + off; }
        const int nig = WGM * nN, gid = wgid / nig, fm = gid * WGM, gsz = (nM - fm) < WGM ? (nM - fm) : WGM;
        u.pm = fm + ((wgid % nig) % gsz); u.pn = (wgid % nig) / gsz; return true;
    }
    __device__ __forceinline__ void a_ready(const Unit&) const {}
    __device__ __forceinline__ void done(const Unit&) const {}
};

__device__ __forceinline__ unsigned cvt_pk_bf16(float lo, float hi) { unsigned r; asm volatile("v_cvt_pk_bf16_f32 %0, %1, %2" : "=v"(r) : "v"(lo), "v"(hi)); return r; }
template <class Epi, class Sched, bool ALIGN_EPI = false, bool SP2 = false>
__device__ __forceinline__ void gemm_phase(PG8_LAS unsigned char* lds, const Gemm g, const Sched& S, const Epi& E) {
    int tid_ = threadIdx.x; asm volatile("" : "+v"(tid_));
    const int tid = tid_, wid = __builtin_amdgcn_readfirstlane(tid >> 6), lane = tid & 63, wr = wid >> 2, wc = wid & 3, fr = lane & 15, fq = lane >> 4;
    const int K = g.K, nt = K / BK;
    unsigned voffA[2], voffB[2];
#pragma unroll
    for (int i = 0; i < 2; ++i) { int R, C; stage_rc(tid * 16 + i * 8192, R, C); const int Rb = Epi::PERM ? ((R & ~31) + perm32(R & 31)) : R;
        voffA[i] = (unsigned)(R * K + C) * 2u; voffB[i] = (unsigned)(Rb * K + C) * 2u; }
    const size_t kstep = (size_t)(BK * 2);
    const size_t hstep = (size_t)HALF * K * 2;
    const size_t tstep = 2 * hstep;
    const unsigned ldsw = (unsigned)wid * 1024u;
    const int aoff = lds_byte(wr * 64 + fr, fq * 8), boff = lds_byte(wc * 32 + fr, fq * 8);
#define PG8_SA(b, h) (((b) * 2 + (h)) * HTB)
#define PG8_SB(b, h) ((4 + (b) * 2 + (h)) * HTB)
#define PG8_STAGE(bufoff, gbase, voff) do { _Pragma("unroll") for (int _i = 0; _i < 2; ++_i) \
        __builtin_amdgcn_global_load_lds((const unsigned*)((const char*)(gbase) + (voff)[_i]), (PG8_LAS unsigned*)(lds + (bufoff) + ldsw + _i * 8192), 16, 0, 0); } while (0)
#define PG8_LDA(dst, b, h) do { _Pragma("unroll") for (int m = 0; m < 4; ++m) _Pragma("unroll") for (int k = 0; k < 2; ++k) dst[m][k] = *(const PG8_LAS bf16x8*)(lds + PG8_SA(b, h) + aoff + m * 2048 + k * 1024); } while (0)
#define PG8_LDB(dst, b, h) do { _Pragma("unroll") for (int n = 0; n < 2; ++n) _Pragma("unroll") for (int k = 0; k < 2; ++k) dst[n][k] = *(const PG8_LAS bf16x8*)(lds + PG8_SB(b, h) + boff + n * 2048 + k * 1024); } while (0)
#define PG8_MMA(ai, bj, At, Bt) do { __builtin_amdgcn_s_setprio(1); _Pragma("unroll") for (int m = 0; m < 4; ++m) _Pragma("unroll") for (int n = 0; n < 2; ++n) _Pragma("unroll") for (int k = 0; k < 2; ++k) \
        acc[ai][bj][m][n] = __builtin_amdgcn_mfma_f32_16x16x32_bf16(Bt[n][k], At[m][k], acc[ai][bj][m][n], 0, 0, 0); __builtin_amdgcn_s_setprio(0); } while (0)
#define PG8_WAIT_V(n) asm volatile("s_waitcnt vmcnt(" #n ")" ::: "memory")
#define PG8_WAIT_L(n) asm volatile("s_waitcnt lgkmcnt(" #n ")" ::: "memory")
#define PG8_BAR __builtin_amdgcn_s_barrier()
#define PG8_SCHED __builtin_amdgcn_sched_barrier(0)
    Unit cur, nxt; int ui = 0;
    if (!S.next(0, cur)) return;
    f32x4 acc[2][2][4][2];
#pragma unroll
    for (int a = 0; a < 2; ++a)
#pragma unroll
        for (int b = 0; b < 2; ++b)
#pragma unroll
            for (int m = 0; m < 4; ++m)
#pragma unroll
                for (int n = 0; n < 2; ++n) acc[a][b][m][n] = (f32x4){0.f, 0.f, 0.f, 0.f};
    bf16x8 At[4][2], B0[2][2], B1[2][2];
    const char* cA = (const char*)g.A + (size_t)cur.pm * tstep; const char* cB = (const char*)g.Bt + (size_t)cur.pn * tstep;
    S.a_ready(cur);
    if constexpr (SP2) {
        PG8_STAGE(PG8_SB(0, 0), cB, voffB); PG8_STAGE(PG8_SB(0, 1), cB + hstep, voffB); PG8_STAGE(PG8_SA(0, 0), cA, voffA); PG8_STAGE(PG8_SA(0, 1), cA + hstep, voffA);
        if (wr == 1) PG8_BAR;
        PG8_WAIT_V(2); PG8_BAR;
        PG8_STAGE(PG8_SB(1, 0), cB + kstep, voffB); PG8_STAGE(PG8_SA(1, 0), cA + kstep, voffA); PG8_STAGE(PG8_SB(1, 1), cB + hstep + kstep, voffB);
        PG8_WAIT_V(6); PG8_BAR;
    } else {
        PG8_STAGE(PG8_SB(0, 0), cB, voffB); PG8_STAGE(PG8_SA(0, 0), cA, voffA); PG8_STAGE(PG8_SB(0, 1), cB + hstep, voffB); PG8_STAGE(PG8_SA(0, 1), cA + hstep, voffA);
        if (wr == 1) PG8_BAR;
        PG8_WAIT_V(4); PG8_BAR;
        PG8_STAGE(PG8_SB(1, 0), cB + kstep, voffB); PG8_STAGE(PG8_SA(1, 0), cA + kstep, voffA); PG8_STAGE(PG8_SB(1, 1), cB + hstep + kstep, voffB);
        PG8_WAIT_V(6); PG8_BAR;
    }
    for (;;) {
        const bool has_next = S.next(ui + 1, nxt);
        const char* nA = has_next ? (const char*)g.A + (size_t)nxt.pm * tstep : cA; const char* nB = has_next ? (const char*)g.Bt + (size_t)nxt.pn * tstep : cB;
        for (int t = 0; t < nt; t += 2) {
            const bool last = (t == nt - 2);
            const char* a1 = cA + (size_t)(t + 1) * kstep;
            const char* a2 = last ? nA : cA + (size_t)(t + 2) * kstep; const char* b2 = last ? nB : cB + (size_t)(t + 2) * kstep;
            const char* a3 = a2 + kstep; const char* b3 = b2 + kstep;
            if (last && has_next) S.a_ready(nxt);
            if constexpr (SP2) {
            PG8_LDB(B0, 0, 0); PG8_LDB(B1, 0, 1); PG8_SCHED; PG8_LDA(At, 0, 0); PG8_STAGE(PG8_SA(1, 1), a1 + hstep, voffA);
            PG8_WAIT_V(8); PG8_WAIT_L(0); PG8_BAR; PG8_MMA(0, 0, At, B0); PG8_MMA(0, 1, At, B1); PG8_BAR; PG8_SCHED;
            PG8_LDA(At, 0, 1); PG8_STAGE(PG8_SB(0, 0), b2, voffB); PG8_STAGE(PG8_SB(0, 1), b2 + hstep, voffB); PG8_STAGE(PG8_SA(0, 0), a2, voffA);
            PG8_WAIT_V(8); PG8_WAIT_L(0); PG8_BAR; PG8_MMA(1, 0, At, B0); PG8_MMA(1, 1, At, B1); PG8_BAR; PG8_SCHED;
            PG8_LDB(B0, 1, 0); PG8_LDB(B1, 1, 1); PG8_SCHED; PG8_LDA(At, 1, 0); PG8_STAGE(PG8_SA(0, 1), a2 + hstep, voffA);
            PG8_WAIT_V(8); PG8_WAIT_L(0); PG8_BAR; PG8_MMA(0, 0, At, B0); PG8_MMA(0, 1, At, B1); PG8_BAR; PG8_SCHED;
            PG8_LDA(At, 1, 1); PG8_STAGE(PG8_SB(1, 0), b3, voffB); PG8_STAGE(PG8_SB(1, 1), b3 + hstep, voffB); PG8_STAGE(PG8_SA(1, 0), a3, voffA);
            PG8_WAIT_V(8); PG8_WAIT_L(0); PG8_BAR; PG8_MMA(1, 0, At, B0); PG8_MMA(1, 1, At, B1); PG8_BAR; PG8_SCHED;
            } else {
            PG8_LDB(B0, 0, 0); PG8_SCHED; PG8_LDA(At, 0, 0); PG8_STAGE(PG8_SA(1, 1), a1 + hstep, voffA);
            PG8_WAIT_L(8); PG8_BAR; PG8_WAIT_L(0); PG8_MMA(0, 0, At, B0); PG8_BAR; PG8_SCHED;
            PG8_LDB(B1, 0, 1); PG8_STAGE(PG8_SB(0, 0), b2, voffB);
            PG8_BAR; PG8_WAIT_L(0); PG8_MMA(0, 1, At, B1); PG8_BAR;
            PG8_LDA(At, 0, 1); PG8_STAGE(PG8_SA(0, 0), a2, voffA);
            PG8_BAR; PG8_WAIT_L(0); PG8_MMA(1, 0, At, B0); PG8_BAR; PG8_SCHED;
            PG8_STAGE(PG8_SB(0, 1), b2 + hstep, voffB);
            PG8_WAIT_V(6); PG8_BAR; PG8_MMA(1, 1, At, B1); PG8_BAR;
            PG8_LDB(B0, 1, 0); PG8_SCHED; PG8_LDA(At, 1, 0); PG8_STAGE(PG8_SA(0, 1), a2 + hstep, voffA);
            PG8_WAIT_L(8); PG8_BAR; PG8_WAIT_L(0); PG8_MMA(0, 0, At, B0); PG8_BAR; PG8_SCHED;
            PG8_LDB(B1, 1, 1); PG8_STAGE(PG8_SB(1, 0), b3, voffB);
            PG8_BAR; PG8_WAIT_L(0); PG8_MMA(0, 1, At, B1); PG8_BAR;
            PG8_LDA(At, 1, 1); PG8_STAGE(PG8_SA(1, 0), a3, voffA);
            PG8_BAR; PG8_WAIT_L(0); PG8_MMA(1, 0, At, B0); PG8_BAR; PG8_SCHED;
            PG8_STAGE(PG8_SB(1, 1), b3 + hstep, voffB);
            PG8_WAIT_V(6); PG8_BAR; PG8_MMA(1, 1, At, B1); PG8_BAR;
            }
        }
        if constexpr (ALIGN_EPI) { if (wr == 0) PG8_BAR; }
        if constexpr (!Epi::AFTER_DRAIN) { E(acc, cur, wr, wc, fr, fq); S.done(cur); }
        if (!has_next) break;
#pragma unroll
        for (int a = 0; a < 2; ++a)
#pragma unroll
            for (int b = 0; b < 2; ++b)
#pragma unroll
                for (int m = 0; m < 4; ++m)
#pragma unroll
                    for (int n = 0; n < 2; ++n) acc[a][b][m][n] = (f32x4){0.f, 0.f, 0.f, 0.f};
        cur = nxt; cA = nA; cB = nB; ++ui;
        if constexpr (ALIGN_EPI) { if (wr == 1) PG8_BAR; }
    }
    PG8_WAIT_V(0);
    if constexpr (!ALIGN_EPI) { if (wr == 0) PG8_BAR; }
    PG8_BAR;
    if constexpr (Epi::AFTER_DRAIN) { E.fused(acc, cur, wr, wc, fr, fq, lds, wid, lane); S.done(cur); }
#undef PG8_SA
#undef PG8_SB
#undef PG8_STAGE
#undef PG8_LDA
#undef PG8_LDB
#undef PG8_MMA
#undef PG8_WAIT_V
#undef PG8_WAIT_L
#undef PG8_BAR
#undef PG8_SCHED
}
}

#define LAS __attribute__((address_space(3)))
typedef unsigned short bf16_t;
typedef short bf16x8 __attribute__((ext_vector_type(8)));
typedef float f32x4 __attribute__((ext_vector_type(4)));
typedef unsigned u32x4 __attribute__((ext_vector_type(4)));
typedef unsigned u32x2 __attribute__((ext_vector_type(2)));

constexpr int DM = 1024, SEQ = 8192, NB = 2, DEPTH = 4, DB = 32, DS = 4;
constexpr int MP = NB * SEQ;
constexpr int MS = DB * DS;
constexpr int MR = MP + MS;
constexpr int MPAD = 16640;
constexpr int FF = 2816, NIN = 3328, ZW = 3072;
constexpr int ZQ = 256, ZK = 512, ZV = 768, ZHQ = 1024, ZHK = 1536, ZHV = 2048, ZHG = 2560;
constexpr float EPS = 1e-6f;
constexpr int NTHR = 512;
constexpr int LDS_BYTES = 151552;

constexpr size_t al256(size_t x) { return (x + 255) & ~(size_t)255; }
constexpr size_t SZ_WGU = (size_t)2 * FF * DM * 2, SZ_WD = (size_t)DM * FF * 2, SZ_WIN = (size_t)NIN * DM * 2, SZ_WO = (size_t)DM * DM * 2;
constexpr size_t WS_WGU = 0;
constexpr size_t WS_WD = WS_WGU + 8 * SZ_WGU;
constexpr size_t WS_WIN = WS_WD + 8 * SZ_WD;
constexpr size_t WS_WO = WS_WIN + 4 * SZ_WIN;
constexpr size_t WS_LB = WS_WO + 4 * SZ_WO;
constexpr size_t WS_X = al256(WS_LB + 4 * 512 * 4);
constexpr size_t WS_XN = WS_X + (size_t)MPAD * DM * 4;
constexpr size_t WS_ACT = WS_XN + (size_t)MPAD * DM * 2;
constexpr size_t WS_ZB = WS_ACT + (size_t)MPAD * FF * 2;
constexpr size_t WS_LF = WS_ZB + (size_t)MPAD * ZW * 2;
constexpr size_t WS_Y = WS_LF + (size_t)MPAD * 512 * 4;
constexpr size_t WS_OP = WS_Y + (size_t)MPAD * DM * 2;
constexpr size_t WS_LSE = WS_OP + (size_t)3 * MP * 256 * 4;
constexpr size_t WS_SL = WS_LSE + (size_t)3 * MP * 4 * 4;
constexpr size_t WS_SP = WS_SL + (size_t)1024 * 16384 * 4;
constexpr size_t WS_DC = WS_SP + (size_t)1024 * 16384 * 2;
constexpr size_t WS_END = WS_DC + (size_t)1024 * 128 * 4;

constexpr size_t O_YP = 0, O_YS = 16777216, O_CP = O_YS + 131072, O_CS = O_CP + 61440, O_KP = O_CS + 983040, O_VP = O_KP + 4194304,
                 O_KS = O_VP + 4194304, O_VS = O_KS + 131072, O_HP = O_VS + 131072, O_HS = O_HP + 524288, O_END = O_HS + 8388608;

struct Args {
    const float* in[24];
    float* out;
    unsigned char* ws;
};

struct Ctx { int tid, lane, wave, G, bid; };
#define WSP(T, off) ((T*)(A.ws + (off)))

__device__ __forceinline__ unsigned f2bf(float f) { unsigned u = __builtin_bit_cast(unsigned, f); return (u + 0x7fffu + ((u >> 16) & 1u)) >> 16; }
__device__ __forceinline__ unsigned pk2(float lo, float hi) { return f2bf(lo) | (f2bf(hi) << 16); }
__device__ __forceinline__ float bf2f(unsigned h) { return __builtin_bit_cast(float, (h & 0xffffu) << 16); }
__device__ __forceinline__ float bflo(unsigned w) { return __builtin_bit_cast(float, w << 16); }
__device__ __forceinline__ float bfhi(unsigned w) { return __builtin_bit_cast(float, w & 0xffff0000u); }
__device__ __forceinline__ float sigmoidf_(float x) { return __builtin_amdgcn_rcpf(1.f + __expf(-x)); }
__device__ __forceinline__ float siluf_(float x) { return x * sigmoidf_(x); }
__device__ __forceinline__ float wave_sum(float v) {
#pragma unroll
    for (int o = 1; o < 64; o <<= 1) v += __shfl_xor(v, o);
    return v;
}
__device__ __forceinline__ float wave_max(float v) {
#pragma unroll
    for (int o = 1; o < 64; o <<= 1) v = fmaxf(v, __shfl_xor(v, o));
    return v;
}
__device__ __forceinline__ float sum16(float v) { v += __shfl_xor(v, 1); v += __shfl_xor(v, 2); v += __shfl_xor(v, 4); v += __shfl_xor(v, 8); return v; }
__device__ __forceinline__ float max16(float v) { v = fmaxf(v, __shfl_xor(v, 1)); v = fmaxf(v, __shfl_xor(v, 2)); v = fmaxf(v, __shfl_xor(v, 4)); v = fmaxf(v, __shfl_xor(v, 8)); return v; }
__device__ __forceinline__ bf16x8 ldfrag(const LAS bf16_t* base, int ld, int r0, int k0, int lane) {
    return *(const LAS bf16x8*)(base + (r0 + (lane & 15)) * ld + k0 + 8 * (lane >> 4));
}
#define MFMA16(a, b, c) __builtin_amdgcn_mfma_f32_16x16x32_bf16((a), (b), (c), 0, 0, 0)
#define LDS_FENCE() asm volatile("s_waitcnt lgkmcnt(0)" ::: "memory")

struct EpiSwiglu {
    static constexpr bool PERM = true, AFTER_DRAIN = false;
    bf16_t* O;
    __device__ __forceinline__ void operator()(const f32x4 (&acc)[2][2][4][2], const pg8::Unit& u_, int wr, int wc_, int fr_, int fq_) const {
        pg8::Unit u = u_; int wc = wc_, fr = fr_, fq = fq_; asm volatile("" : "+s"(u.pm), "+s"(u.pn), "+v"(fr), "+v"(fq), "+s"(wc));
        const int row0 = u.pm * 256 + wr * 64 + fr, col0 = u.pn * 128 + wc * 32 + 8 * fq;
#pragma unroll
        for (int ai = 0; ai < 2; ++ai)
#pragma unroll
            for (int m = 0; m < 4; ++m) {
                bf16_t* rowp = O + (size_t)(row0 + ai * 128 + m * 16) * FF + col0;
                float v[8];
#pragma unroll
                for (int n = 0; n < 2; ++n)
#pragma unroll
                    for (int i = 0; i < 4; ++i) v[n * 4 + i] = siluf_(acc[ai][0][m][n][i]) * acc[ai][1][m][n][i];
                u32x4 w; w.x = pk2(v[0], v[1]); w.y = pk2(v[2], v[3]); w.z = pk2(v[4], v[5]); w.w = pk2(v[6], v[7]);
                *(u32x4*)rowp = w;
            }
    }
};
struct EpiResid {
    static constexpr bool PERM = false, AFTER_DRAIN = false;
    float* X;
    __device__ __forceinline__ void operator()(const f32x4 (&acc)[2][2][4][2], const pg8::Unit& u_, int wr, int wc_, int fr_, int fq_) const {
        pg8::Unit u = u_; int wc = wc_, fr = fr_, fq = fq_; asm volatile("" : "+s"(u.pm), "+s"(u.pn), "+v"(fr), "+v"(fq), "+s"(wc));
        const int row0 = u.pm * 256 + wr * 64 + fr, col0 = u.pn * 256 + wc * 32 + 4 * fq;
#pragma unroll
        for (int ai = 0; ai < 2; ++ai)
#pragma unroll
            for (int m = 0; m < 4; ++m) {
                float* p = X + (size_t)(row0 + ai * 128 + m * 16) * DM + col0;
                f32x4 t[2][2];
#pragma unroll
                for (int bj = 0; bj < 2; ++bj)
#pragma unroll
                    for (int n = 0; n < 2; ++n) t[bj][n] = *(const f32x4*)(p + bj * 128 + n * 16);
#pragma unroll
                for (int bj = 0; bj < 2; ++bj)
#pragma unroll
                    for (int n = 0; n < 2; ++n) *(f32x4*)(p + bj * 128 + n * 16) = t[bj][n] + acc[ai][bj][m][n];
                if (m & 1) asm volatile("" ::: "memory");
            }
    }
};
struct EpiWin {
    static constexpr bool PERM = true, AFTER_DRAIN = false;
    bf16_t* ZB; float* LF; const float* LB  ; float* outK; float* outV; float* outKs; float* outVs;
    __device__ __forceinline__ void operator()(const f32x4 (&acc)[2][2][4][2], const pg8::Unit& u_, int wr, int wc_, int fr_, int fq_) const {
        pg8::Unit u = u_; int wc = wc_, fr = fr_, fq = fq_; asm volatile("" : "+s"(u.pm), "+s"(u.pn), "+v"(fr), "+v"(fq), "+s"(wc));
        const int row0 = u.pm * 256 + wr * 64 + fr; const int pn = u.pn; const int cw = wc * 32 + 8 * fq;
        if (pn < 2) {
#pragma unroll
            for (int ai = 0; ai < 2; ++ai)
#pragma unroll
                for (int m = 0; m < 4; ++m) {
                    const int row = row0 + ai * 128 + m * 16; float v[8];
#pragma unroll
                    for (int n = 0; n < 2; ++n)
#pragma unroll
                        for (int i = 0; i < 4; ++i) v[n * 4 + i] = acc[ai][0][m][n][i] * sigmoidf_(acc[ai][1][m][n][i]);
                    u32x4 w; w.x = pk2(v[0], v[1]); w.y = pk2(v[2], v[3]); w.z = pk2(v[4], v[5]); w.w = pk2(v[6], v[7]);
                    *(u32x4*)(ZB + (size_t)row * ZW + pn * 128 + cw) = w;
                }
            return;
        }
        int zcol; int kind;
        if (pn == 2) { zcol = ZQ; kind = 0; } else if (pn == 3) { zcol = ZK; kind = 1; } else if (pn == 4) { zcol = ZV; kind = 2; }
        else if (pn < 7) { zcol = ZHQ + (pn - 5) * 256; kind = 3; } else if (pn < 9) { zcol = ZHK + (pn - 7) * 256; kind = 4; }
        else if (pn < 11) { zcol = ZHV + (pn - 9) * 256; kind = 5; } else { zcol = ZHG + (pn - 11) * 256; kind = 3; }
#pragma unroll
        for (int bj = 0; bj < 2; ++bj) {
            const int cin = bj * 128 + cw;
            float lb[8];
            if (kind == 4) {
#pragma unroll
                for (int i = 0; i < 8; ++i) lb[i] = LB[(pn - 7) * 256 + cin + i];
            }
#pragma unroll
            for (int ai = 0; ai < 2; ++ai)
#pragma unroll
                for (int m = 0; m < 4; ++m) {
                    const int row = row0 + ai * 128 + m * 16; float v[8];
#pragma unroll
                    for (int n = 0; n < 2; ++n)
#pragma unroll
                        for (int i = 0; i < 4; ++i) v[n * 4 + i] = acc[ai][bj][m][n][i];
                    if (kind == 1 || kind == 2) {
                        float* dst = nullptr;
                        if (row < MP) { const int b = row >> 13, t = row & (SEQ - 1); if (t >= SEQ - 2048) dst = (kind == 1 ? outK : outV) + ((size_t)(b * 2048 + (t - (SEQ - 2048))) * 256 + cin); }
                        else if (row < MR) dst = (kind == 1 ? outKs : outVs) + ((size_t)(row - MP) * 256 + cin);
                        if (dst) { *(f32x4*)dst = (f32x4){v[0], v[1], v[2], v[3]}; *(f32x4*)(dst + 4) = (f32x4){v[4], v[5], v[6], v[7]}; }
                    }
                    if (kind == 0) {
#pragma unroll
                        for (int i = 0; i < 8; ++i) v[i] *= 0.125f;
                    } else if (kind == 3) {
#pragma unroll
                        for (int i = 0; i < 8; ++i) v[i] = siluf_(v[i]);
                    } else if (kind == 4) {
                        float lf[8];
#pragma unroll
                        for (int i = 0; i < 8; ++i) { const float sg = sigmoidf_(v[i]); const float f = lb[i] + (1.f - lb[i]) * sg; lf[i] = __logf(f); v[i] = (1.f - lb[i]) * sigmoidf_(-v[i]); }
                        float* lp = LF + (size_t)row * 512 + (pn - 7) * 256 + cin;
                        *(f32x4*)lp = (f32x4){lf[0], lf[1], lf[2], lf[3]}; *(f32x4*)(lp + 4) = (f32x4){lf[4], lf[5], lf[6], lf[7]};
                    }
                    u32x4 w; w.x = pk2(v[0], v[1]); w.y = pk2(v[2], v[3]); w.z = pk2(v[4], v[5]); w.w = pk2(v[6], v[7]);
                    *(u32x4*)(ZB + (size_t)row * ZW + zcol + cin) = w;
                }
        }
    }
};

__device__ __forceinline__ void transpose_item(const float* W, int K, int N, int k0, int n0, bf16_t* dst, LAS float* scr, int lane, float wscale = 1.0f) {
#pragma unroll 8
    for (int i = 0; i < 32; ++i) { const int kk = 2 * i + (lane >> 5); scr[kk * 33 + (lane & 31)] = wscale * W[(size_t)(k0 + kk) * N + n0 + (lane & 31)]; }
    LDS_FENCE();
    const int c = lane & 7;
#pragma unroll
    for (int j = 0; j < 4; ++j) { const int n = (lane >> 3) + 8 * j; const LAS float* s = scr + (8 * c) * 33 + n;
        u32x4 o; o.x = pk2(s[0 * 33], s[1 * 33]); o.y = pk2(s[2 * 33], s[3 * 33]); o.z = pk2(s[4 * 33], s[5 * 33]); o.w = pk2(s[6 * 33], s[7 * 33]);
        *(u32x4*)(dst + (size_t)n * K + k0 + 8 * c) = o; }
    LDS_FENCE();
}
constexpr int IT_GU = 16 * 88, IT_D = 44 * 32, IT_FFN = 2 * IT_GU + IT_D, IT_WIN = 16 * 104, IT_WO = 16 * 32, IT_LAYER = 2 * IT_FFN + IT_WIN + IT_WO;
__device__ __forceinline__ void weight_item(const Args& A, const Ctx& C, int it, LAS float* scr) {
    const int l = it / IT_LAYER; int r = it % IT_LAYER;
    if (r < 2 * IT_FFN) {
        const int f = r / IT_FFN; const int q = r % IT_FFN;
        if (q < 2 * IT_GU) {
            const int which = q / IT_GU, idx = q % IT_GU, kb = idx / 88, nb = idx % 88, n0 = nb * 32;
            const float* W = (f == 0 ? (which == 0 ? A.in[7] : A.in[8]) : (which == 0 ? A.in[20] : A.in[21])) + (size_t)l * DM * FF;
            const int drow = (n0 >> 7) * 256 + (n0 & 127) + which * 128;
            bf16_t* dst = (bf16_t*)(A.ws + WS_WGU + (size_t)(l * 2 + f) * SZ_WGU) + (size_t)drow * DM;
            transpose_item(W, DM, FF, kb * 64, n0, dst, scr, C.lane);
        } else {
            const int idx = q - 2 * IT_GU, kb = idx / 32, nb = idx % 32, n0 = nb * 32;
            const float* W = (f == 0 ? A.in[9] : A.in[22]) + (size_t)l * FF * DM;
            bf16_t* dst = (bf16_t*)(A.ws + WS_WD + (size_t)(l * 2 + f) * SZ_WD) + (size_t)n0 * FF;
            transpose_item(W, FF, DM, kb * 64, n0, dst, scr, C.lane, 0.5f);
        }
        return;
    }
    r -= 2 * IT_FFN;
    if (r < IT_WIN) {
        const int kb = r / 104, nb = r % 104, n0 = nb * 32;
        const float* W = A.in[11] + (size_t)l * DM * NIN;
        int drow = n0;
        if (n0 < 256) drow = (n0 >> 7) * 256 + (n0 & 127);
        else if (n0 < 512) { const int j = n0 - 256; drow = (j >> 7) * 256 + 128 + (j & 127); }
        bf16_t* dst = (bf16_t*)(A.ws + WS_WIN + (size_t)l * SZ_WIN) + (size_t)drow * DM;
        transpose_item(W, DM, NIN, kb * 64, n0, dst, scr, C.lane);
        return;
    }
    r -= IT_WIN;
    {
        const int kb = r / 32, nb = r % 32, n0 = nb * 32;
        const float* W = A.in[18] + (size_t)l * DM * DM;
        bf16_t* dst = (bf16_t*)(A.ws + WS_WO + (size_t)l * SZ_WO) + (size_t)n0 * DM;
        transpose_item(W, DM, DM, kb * 64, n0, dst, scr, C.lane);
    }
}

template <int MODE>
__device__ __forceinline__ void norm_phase(const Args& A, const Ctx& C, const float* g) {
    int lane_ = C.lane; asm volatile("" : "+v"(lane_));
    const int gw = C.bid * 8 + C.wave, NGW = C.G * 8;
    f32x4 gv[4];
#pragma unroll
    for (int j = 0; j < 4; ++j) gv[j] = ((const f32x4*)g)[lane_ + 64 * j];
    for (int m = gw; m < MR; m += NGW) {
        const float* src = (MODE == 1) ? (m < MP ? A.in[0] + (size_t)m * DM : A.in[1] + (size_t)(m - MP) * DM) : WSP(float, WS_X) + (size_t)m * DM;
        const f32x4* xr = (const f32x4*)src + lane_;
        f32x4 v[4]; float s = 0.f;
#pragma unroll
        for (int j = 0; j < 4; ++j) { v[j] = xr[64 * j]; s += (v[j].x * v[j].x + v[j].y * v[j].y) + (v[j].z * v[j].z + v[j].w * v[j].w); }
        const float rstd = 1.0f / sqrtf(wave_sum(s) * (1.f / DM) + EPS);
        if (MODE == 1) {
            f32x4* xo = (f32x4*)(WSP(float, WS_X) + (size_t)m * DM) + lane_;
#pragma unroll
            for (int j = 0; j < 4; ++j) xo[64 * j] = v[j];
        }
        if (MODE == 2) {
            f32x4* yo = (f32x4*)(A.out + (size_t)m * DM) + lane_;
#pragma unroll
            for (int j = 0; j < 4; ++j) yo[64 * j] = v[j] * rstd * gv[j];
        } else {
            u32x2* o8 = (u32x2*)(WSP(bf16_t, WS_XN) + (size_t)m * DM) + lane_;
#pragma unroll
            for (int j = 0; j < 4; ++j) { const f32x4 y = v[j] * rstd * gv[j]; u32x2 w; w.x = pk2(y.x, y.y); w.y = pk2(y.z, y.w); o8[64 * j] = w; }
        }
    }
}

__device__ __forceinline__ void prologue_phase(const Args& A, const Ctx& C, LAS unsigned char* lds) {
    LAS float* scr = (LAS float*)(lds + C.wave * 16384);
    const int gw = C.bid * 8 + C.wave, NGW = C.G * 8;
    for (int it = gw; it < DEPTH * IT_LAYER; it += NGW) weight_item(A, C, it, scr);
    const int gt = C.bid * NTHR + C.tid, NGT = C.G * NTHR;
    for (int c = gt; c < 512; c += NGT) {
        float v[4], mx = -1e30f;
#pragma unroll
        for (int l = 0; l < 4; ++l) { v[l] = A.in[16][l * 512 + c]; mx = fmaxf(mx, v[l]); }
        float s = 0.f;
#pragma unroll
        for (int l = 0; l < 4; ++l) { v[l] = __expf(v[l] - mx); s += v[l]; }
        const float inv = 1.f / s; float cum = 0.f;
        WSP(float, WS_LB)[c] = 0.f;
#pragma unroll
        for (int l = 1; l < 4; ++l) { cum += v[l] * inv; WSP(float, WS_LB)[l * 512 + c] = cum; }
    }
    for (int i = gt; i < (MPAD - MR) * DM; i += NGT) { WSP(float, WS_X)[(size_t)MR * DM + i] = 0.f; WSP(bf16_t, WS_XN)[(size_t)MR * DM + i] = 0; WSP(bf16_t, WS_Y)[(size_t)MR * DM + i] = 0; }
    norm_phase<1>(A, C, A.in[6]);
}

__device__ __forceinline__ void attn_item(const Args& A, const Ctx& C, int item, LAS unsigned char* lds) {
    const int br = item >> 9, rem = item & 511, b = rem >> 8, h = (rem >> 6) & 3, n = rem & 63;
    const int sh = 2 * br, nbc = 64 >> sh, r = n / nbc, cb = n % nbc;
    LAS bf16_t* Qs = (LAS bf16_t*)lds;
    LAS bf16_t* Ks = Qs + 128 * 72;
    LAS bf16_t* VT = Ks + 256 * 72;
    LAS bf16_t* Ps = VT + 64 * 280;
    const bf16_t* Zb = WSP(bf16_t, WS_ZB) + (size_t)(b * SEQ) * ZW;
    int tid = C.tid, w = C.wave; asm volatile("" : "+v"(tid), "+s"(w)); const int lane = tid & 63, fr = lane & 15, fq = lane >> 4;
    __syncthreads();
    for (int i = tid; i < 1024; i += NTHR) { const int qi = i >> 3, ch = i & 7; const int t = ((cb * 128 + qi) << sh) + r;
        const u32x4 v = *(const u32x4*)(Zb + (size_t)t * ZW + ZQ + h * 64 + ch * 8); *(LAS u32x4*)(Qs + qi * 72 + ch * 8) = v; }
    for (int i = tid; i < 2048; i += NTHR) { const int ki = i >> 3, ch = i & 7; const int u = (cb - 1) * 128 + ki;
        u32x4 kv = (u32x4){0u, 0u, 0u, 0u}, vv = (u32x4){0u, 0u, 0u, 0u};
        if (u >= 0) { const int t = (u << sh) + r; const bf16_t* p = Zb + (size_t)t * ZW + h * 64 + ch * 8; kv = *(const u32x4*)(p + ZK); vv = *(const u32x4*)(p + ZV); }
        *(LAS u32x4*)(Ks + ki * 72 + ch * 8) = kv;
        LAS bf16_t* vt = VT + (ch * 8) * 280 + ki;
        vt[0 * 280] = (bf16_t)(vv.x & 0xffffu); vt[1 * 280] = (bf16_t)(vv.x >> 16); vt[2 * 280] = (bf16_t)(vv.y & 0xffffu); vt[3 * 280] = (bf16_t)(vv.y >> 16);
        vt[4 * 280] = (bf16_t)(vv.z & 0xffffu); vt[5 * 280] = (bf16_t)(vv.z >> 16); vt[6 * 280] = (bf16_t)(vv.w & 0xffffu); vt[7 * 280] = (bf16_t)(vv.w >> 16); }
    for (int i = tid; i < 1024; i += NTHR) VT[(i >> 4) * 280 + 256 + (i & 15)] = 0;
    __syncthreads();
    f32x4 s[9];
    {
        bf16x8 aq[2];
#pragma unroll
        for (int k = 0; k < 2; ++k) aq[k] = ldfrag(Qs, 72, 16 * w, 32 * k, lane);
#pragma unroll
        for (int j = 0; j < 9; ++j) { s[j] = (f32x4){0.f, 0.f, 0.f, 0.f};
#pragma unroll
            for (int k = 0; k < 2; ++k) { const bf16x8 bk = ldfrag(Ks, 72, 16 * (w + j), 32 * k, lane); s[j] = MFMA16(aq[k], bk, s[j]); } }
    }
    const float slope = exp2f(-2.f * (float)(h + 1));
    float mx[4] = {-1e30f, -1e30f, -1e30f, -1e30f};
#pragma unroll
    for (int j = 0; j < 9; ++j)
#pragma unroll
        for (int i = 0; i < 4; ++i) {
            const int qi = 16 * w + 4 * fq + i, ki = 16 * (w + j) + fr, jd = qi - ki + 128;
            const bool valid = (jd >= 0) && (jd <= 128) && (cb > 0 || ki >= 128);
            const float val = s[j][i] - slope * (float)(jd << sh);
            s[j][i] = valid ? val : -1e30f; mx[i] = fmaxf(mx[i], s[j][i]);
        }
    float ls[4];
#pragma unroll
    for (int i = 0; i < 4; ++i) { mx[i] = max16(mx[i]); ls[i] = 0.f; }
    LAS bf16_t* Pw = Ps + w * 16 * 168;
#pragma unroll
    for (int j = 0; j < 9; ++j)
#pragma unroll
        for (int i = 0; i < 4; ++i) { const float p = __expf(s[j][i] - mx[i]); ls[i] += p; Pw[(4 * fq + i) * 168 + j * 16 + fr] = (bf16_t)f2bf(p); }
#pragma unroll
    for (int e = 0; e < 4; ++e) { const int idx = lane * 4 + e; Pw[(idx >> 4) * 168 + 144 + (idx & 15)] = 0; }
#pragma unroll
    for (int i = 0; i < 4; ++i) ls[i] = sum16(ls[i]);
    LDS_FENCE();
    f32x4 o[4];
#pragma unroll
    for (int d = 0; d < 4; ++d) o[d] = (f32x4){0.f, 0.f, 0.f, 0.f};
#pragma unroll
    for (int ks = 0; ks < 5; ++ks) { const bf16x8 ap = ldfrag(Pw, 168, 0, 32 * ks, lane);
#pragma unroll
        for (int d = 0; d < 4; ++d) { const bf16x8 bv = ldfrag(VT, 280, 16 * d, 16 * w + 32 * ks, lane); o[d] = MFMA16(ap, bv, o[d]); } }
    float* OPb = WSP(float, WS_OP) + (size_t)br * MP * 256; float* LSb = WSP(float, WS_LSE) + (size_t)br * MP * 4;
#pragma unroll
    for (int i = 0; i < 4; ++i) {
        const int qi = 16 * w + 4 * fq + i; const int t = ((cb * 128 + qi) << sh) + r; const size_t grow = (size_t)b * SEQ + t;
        const float inv = 1.f / ls[i];
#pragma unroll
        for (int d = 0; d < 4; ++d) OPb[grow * 256 + h * 64 + 16 * d + fr] = o[d][i] * inv;
        if (fr == 0) LSb[grow * 4 + h] = mx[i] + __logf(ls[i]);
    }
}

__device__ __forceinline__ void chunk_cumsum(const float* src, LAS float* Bc, LAS float* Tot, int tid) {
    const int d = tid & 127, part = tid >> 7;
    float run = 0.f;
#pragma unroll
    for (int s = 0; s < 16; ++s) { run += src[(size_t)(part * 16 + s) * 512 + d]; Bc[(part * 16 + s) * 128 + d] = run; }
    Tot[part * 128 + d] = run;
    __syncthreads();
    float off = 0.f;
#pragma unroll
    for (int p = 0; p < 3; ++p) if (p < part) off += Tot[p * 128 + d];
#pragma unroll
    for (int s = 0; s < 16; ++s) Bc[(part * 16 + s) * 128 + d] += off;
    __syncthreads();
}
constexpr int H_BC = 0, H_TOT = 32768, H_A = 34816;
__device__ __forceinline__ void h1_item(const Args& A, const Ctx& C, int item, LAS unsigned char* lds) {
    const int bh = item >> 7, c = item & 127, b = bh >> 2, h = bh & 3; const size_t row0 = (size_t)b * SEQ + c * 64;
    LAS float* Bc = (LAS float*)(lds + H_BC); LAS float* Tot = (LAS float*)(lds + H_TOT);
    LAS bf16_t* KT = (LAS bf16_t*)(lds + H_A);
    LAS bf16_t* VT = KT + 128 * 72;
    int tid = C.tid, w = C.wave; asm volatile("" : "+v"(tid), "+s"(w)); const int lane = tid & 63, fr = lane & 15, fq = lane >> 4;
    __syncthreads();
    chunk_cumsum(WSP(float, WS_LF) + row0 * 512 + h * 128, Bc, Tot, tid);
    for (int i = tid; i < 1024; i += NTHR) { const int s = i >> 4, ch = i & 15, d0 = ch * 8;
        const bf16_t* p = WSP(bf16_t, WS_ZB) + (row0 + s) * ZW + h * 128 + d0;
        const u32x4 kk = *(const u32x4*)(p + ZHK), vv = *(const u32x4*)(p + ZHV);
        const unsigned kw[4] = {kk.x, kk.y, kk.z, kk.w}, vw[4] = {vv.x, vv.y, vv.z, vv.w};
#pragma unroll
        for (int e = 0; e < 8; ++e) { const int d = d0 + e; const float kf = (e & 1) ? bfhi(kw[e >> 1]) : bflo(kw[e >> 1]);
            const float kt = kf * __expf(Bc[63 * 128 + d] - Bc[s * 128 + d]);
            KT[d * 72 + s] = (bf16_t)f2bf(kt);
            VT[d * 72 + s] = (bf16_t)((e & 1) ? (vw[e >> 1] >> 16) : (vw[e >> 1] & 0xffffu)); } }
    __syncthreads();
    f32x4 acc[8];
#pragma unroll
    for (int j = 0; j < 8; ++j) acc[j] = (f32x4){0.f, 0.f, 0.f, 0.f};
#pragma unroll
    for (int k = 0; k < 2; ++k) { const bf16x8 av = ldfrag(VT, 72, 16 * w, 32 * k, lane);
#pragma unroll
        for (int j = 0; j < 8; ++j) { const bf16x8 bk = ldfrag(KT, 72, 16 * j, 32 * k, lane); acc[j] = MFMA16(av, bk, acc[j]); } }
    float* SLi = WSP(float, WS_SL) + (size_t)item * 16384;
#pragma unroll
    for (int j = 0; j < 8; ++j)
#pragma unroll
        for (int i = 0; i < 4; ++i) SLi[(16 * w + 4 * fq + i) * 128 + 16 * j + fr] = acc[j][i];
    if (tid < 128) WSP(float, WS_DC)[(size_t)item * 128 + tid] = __expf(Bc[63 * 128 + tid]);
}

__device__ __forceinline__ void conv_item(const Args& A, const Ctx& C, int l, int item, LAS unsigned char* lds) {
    const int b = item >> 7, tt = item & 127, t0 = tt * 64;
    LAS bf16_t* Us = (LAS bf16_t*)lds;
    LAS float* Ys = (LAS float*)(lds + 48128);
    int tid = C.tid, w = C.wave; asm volatile("" : "+v"(tid), "+s"(w)); const int lane = tid & 63;
    __syncthreads();
    for (int i = tid; i < 94 * 32; i += NTHR) { const int rr = i >> 5, ch = i & 31; const int t = t0 - 30 + rr;
        u32x4 v = (u32x4){0u, 0u, 0u, 0u};
        if (t >= 0) v = *(const u32x4*)(WSP(bf16_t, WS_ZB) + ((size_t)b * SEQ + t) * ZW + ch * 8);
        *(LAS u32x4*)(Us + rr * 256 + ch * 8) = v; }
    __syncthreads();
    {
        const int c = tid & 255, half = tid >> 8;
        const float* Wl = A.in[12] + (size_t)l * 31 * 256;
        float wv[31];
#pragma unroll
        for (int k = 0; k < 31; ++k) wv[k] = Wl[k * 256 + c];
        const float bias = A.in[13][l * 256 + c];
        float acc[32];
#pragma unroll
        for (int k = 0; k < 32; ++k) acc[k] = bias;
#pragma unroll
        for (int i = 0; i < 62; ++i) {
            const float x = bf2f(Us[(half * 32 + i) * 256 + c]);
#pragma unroll
            for (int k = 0; k < 32; ++k) { if (i - k >= 0 && i - k <= 30) acc[k] += wv[i - k] * x; }
        }
#pragma unroll
        for (int k = 0; k < 32; ++k) Ys[(half * 32 + k) * 257 + c] = acc[k];
    }
    __syncthreads();
    {
        const float* gl = A.in[14] + l * 256; const float* bl = A.in[15] + l * 256;
        float gg[4], bb[4];
#pragma unroll
        for (int j = 0; j < 4; ++j) { gg[j] = gl[lane + 64 * j]; bb[j] = bl[lane + 64 * j]; }
        for (int k = 0; k < 8; ++k) {
            const int tl = w * 8 + k; float v[4]; float s = 0.f;
#pragma unroll
            for (int j = 0; j < 4; ++j) { v[j] = Ys[tl * 257 + lane + 64 * j]; s += v[j]; }
            const float mean = wave_sum(s) * (1.f / 256.f); float q = 0.f;
#pragma unroll
            for (int j = 0; j < 4; ++j) { v[j] -= mean; q += v[j] * v[j]; }
            const float rstd = 1.0f / sqrtf(wave_sum(q) * (1.f / 256.f) + EPS);
            bf16_t* yo = WSP(bf16_t, WS_Y) + ((size_t)b * SEQ + t0 + tl) * DM;
#pragma unroll
            for (int j = 0; j < 4; ++j) yo[lane + 64 * j] = (bf16_t)f2bf(siluf_(v[j] * rstd * gg[j] + bb[j]));
        }
    }
    if (tt == 127) {
        float* oc = A.out + O_CP + (size_t)(l * 2 + b) * 30 * 256;
        for (int i = tid; i < 30 * 256; i += NTHR) oc[i] = bf2f(Us[64 * 256 + i]);
    }
}
__device__ __forceinline__ void conv_sample_item(const Args& A, const Ctx& C, int l, int b, LAS unsigned char* lds) {
    LAS float* Fs = (LAS float*)lds;
    LAS float* Ys = (LAS float*)(lds + 34816);
    int tid = C.tid, w = C.wave; asm volatile("" : "+v"(tid), "+s"(w)); const int lane = tid & 63;
    __syncthreads();
    const float* st = A.in[2] + (size_t)(l * DB + b) * 30 * 256;
    for (int i = tid; i < 30 * 256; i += NTHR) Fs[i] = st[i];
    for (int i = tid; i < 4 * 256; i += NTHR) Fs[30 * 256 + i] = bf2f(WSP(bf16_t, WS_ZB)[((size_t)MP + 4 * b + (i >> 8)) * ZW + (i & 255)]);
    __syncthreads();
    {
        const int c = tid & 255, half = tid >> 8;
        const float* Wl = A.in[12] + (size_t)l * 31 * 256;
        const float bias = A.in[13][l * 256 + c];
        float a0 = bias, a1 = bias;
#pragma unroll
        for (int k = 0; k < 31; ++k) { const float wk = Wl[k * 256 + c]; a0 += wk * Fs[(2 * half + k) * 256 + c]; a1 += wk * Fs[(2 * half + 1 + k) * 256 + c]; }
        Ys[(2 * half) * 257 + c] = a0; Ys[(2 * half + 1) * 257 + c] = a1;
    }
    __syncthreads();
    if (w < 4) {
        const float* gl = A.in[14] + l * 256; const float* bl = A.in[15] + l * 256;
        float v[4]; float s = 0.f;
#pragma unroll
        for (int j = 0; j < 4; ++j) { v[j] = Ys[w * 257 + lane + 64 * j]; s += v[j]; }
        const float mean = wave_sum(s) * (1.f / 256.f); float q = 0.f;
#pragma unroll
        for (int j = 0; j < 4; ++j) { v[j] -= mean; q += v[j] * v[j]; }
        const float rstd = 1.0f / sqrtf(wave_sum(q) * (1.f / 256.f) + EPS);
        bf16_t* yo = WSP(bf16_t, WS_Y) + ((size_t)MP + 4 * b + w) * DM;
#pragma unroll
        for (int j = 0; j < 4; ++j) yo[lane + 64 * j] = (bf16_t)f2bf(siluf_(v[j] * rstd * gl[lane + 64 * j] + bl[lane + 64 * j]));
    }
    float* oc = A.out + O_CS + (size_t)(l * DB + b) * 30 * 256;
    for (int i = tid; i < 30 * 256; i += NTHR) oc[i] = Fs[4 * 256 + i];
}
__device__ __forceinline__ void attn_sample_item(const Args& A, const Ctx& C, int l, int item, LAS unsigned char* lds) {
    int tid = C.tid, w = C.wave; asm volatile("" : "+v"(tid), "+s"(w)); const int lane = tid & 63; const int idx = item * 8 + w; const int b = idx >> 4, t = (idx >> 2) & 3, h = idx & 3;
    LAS float* qs = (LAS float*)(lds + w * 1024);
    LAS float* ps = qs + 64;
    __syncthreads();
    const size_t srow = (size_t)MP + 4 * b + t;
    qs[lane] = bf2f(WSP(bf16_t, WS_ZB)[srow * ZW + ZQ + h * 64 + lane]);
    LDS_FENCE();
    const float slope = exp2f(-2.f * (float)(h + 1));
    const float* ck = A.in[3] + (size_t)(l * DB + b) * 2048 * 256 + h * 64;
    const float* cv = A.in[4] + (size_t)(l * DB + b) * 2048 * 256 + h * 64;
    float M = -1e30f, L = 0.f, O = 0.f;
#pragma unroll 1
    for (int br = 0; br < 3; ++br) {
        const int sh = 2 * br;
        float sc[3];
#pragma unroll
        for (int jj = 0; jj < 3; ++jj) {
            const int j = lane + 64 * jj; float sv = -1e30f;
            if (j <= 128) {
                const int ix = 2048 + t - (j << sh); float dot = 0.f;
                if (ix < 2048) { const f32x4* kp = (const f32x4*)(ck + (size_t)ix * 256);
#pragma unroll
                    for (int c4 = 0; c4 < 16; ++c4) { const f32x4 kv = kp[c4]; const f32x4 qv = *(const LAS f32x4*)(qs + 4 * c4); dot += (kv.x * qv.x + kv.y * qv.y) + (kv.z * qv.z + kv.w * qv.w); } }
                else { const bf16_t* kp = WSP(bf16_t, WS_ZB) + ((size_t)MP + 4 * b + (ix - 2048)) * ZW + ZK + h * 64;
#pragma unroll 8
                    for (int d = 0; d < 64; ++d) dot += bf2f(kp[d]) * qs[d]; }
                sv = dot - slope * (float)(j << sh);
            }
            sc[jj] = sv;
            asm volatile("" ::: "memory");
        }
        const float m = wave_max(fmaxf(fmaxf(sc[0], sc[1]), sc[2]));
        float lsum = 0.f;
#pragma unroll
        for (int jj = 0; jj < 3; ++jj) { const float p = __expf(sc[jj] - m); lsum += p; ps[lane + 64 * jj] = p; }
        lsum = wave_sum(lsum);
        LDS_FENCE();
        float o = 0.f;
#pragma unroll 4
        for (int j = 0; j <= 128; ++j) {
            const int ix = 2048 + t - (j << sh);
            const float v = (ix < 2048) ? cv[(size_t)ix * 256 + lane] : bf2f(WSP(bf16_t, WS_ZB)[((size_t)MP + 4 * b + (ix - 2048)) * ZW + ZV + h * 64 + lane]);
            o += ps[j] * v;
        }
        LDS_FENCE();
        const float Mn = fmaxf(M, m), e0 = __expf(M - Mn), e1 = __expf(m - Mn);
        O = O * e0 + o * e1; L = L * e0 + lsum * e1; M = Mn;
    }
    WSP(bf16_t, WS_Y)[srow * DM + 256 + h * 64 + lane] = (bf16_t)f2bf(O / L);
}
__device__ __forceinline__ void hgrn_sample_item(const Args& A, const Ctx& C, int l, int item, LAS unsigned char* lds) {
    const int b = item >> 2, h = item & 3; int tid = C.tid, w = C.wave; asm volatile("" : "+v"(tid), "+s"(w)); const int lane = tid & 63;
    LAS float* fs = (LAS float*)lds;
    LAS float* ks = fs + 512;
    LAS float* qq = ks + 512;
    LAS float* red = qq + 512;
    __syncthreads();
    { const int t = tid >> 7, d = tid & 127; const size_t row = (size_t)MP + 4 * b + t;
      fs[tid] = __expf(WSP(float, WS_LF)[row * 512 + h * 128 + d]); ks[tid] = bf2f(WSP(bf16_t, WS_ZB)[row * ZW + ZHK + h * 128 + d]); qq[tid] = bf2f(WSP(bf16_t, WS_ZB)[row * ZW + ZHQ + h * 128 + d]); }
    __syncthreads();
    const int v = tid & 127, dq = tid >> 7;
    const float* S0 = A.in[5] + (size_t)((l * DB + b) * 4 + h) * 16384;
    float S[32];
#pragma unroll
    for (int j = 0; j < 32; ++j) S[j] = S0[(dq * 32 + j) * 128 + v];
#pragma unroll
    for (int t = 0; t < 4; ++t) {
        const float vt = bf2f(WSP(bf16_t, WS_ZB)[((size_t)MP + 4 * b + t) * ZW + ZHV + h * 128 + v]);
        float op = 0.f;
#pragma unroll
        for (int j = 0; j < 32; ++j) { const int d = dq * 32 + j; S[j] = fs[t * 128 + d] * S[j] + ks[t * 128 + d] * vt; op += S[j] * qq[t * 128 + d]; }
        red[(t * 4 + dq) * 128 + v] = op;
    }
    float* So = A.out + O_HS + (size_t)((l * DB + b) * 4 + h) * 16384;
#pragma unroll
    for (int j = 0; j < 32; ++j) So[(dq * 32 + j) * 128 + v] = S[j];
    __syncthreads();
    if (w < 4) {
        const int t = w; const size_t row = (size_t)MP + 4 * b + t; const float* gn = A.in[17] + l * 128;
        float o[2]; float ss = 0.f;
#pragma unroll
        for (int j = 0; j < 2; ++j) { const int vv = lane + 64 * j; o[j] = red[(t * 4 + 0) * 128 + vv] + red[(t * 4 + 1) * 128 + vv] + red[(t * 4 + 2) * 128 + vv] + red[(t * 4 + 3) * 128 + vv]; ss += o[j] * o[j]; }
        const float rstd = 1.0f / sqrtf(wave_sum(ss) * (1.f / 128.f) + EPS);
#pragma unroll
        for (int j = 0; j < 2; ++j) { const int vv = lane + 64 * j; const float g = bf2f(WSP(bf16_t, WS_ZB)[row * ZW + ZHG + h * 128 + vv]);
            WSP(bf16_t, WS_Y)[row * DM + 512 + h * 128 + vv] = (bf16_t)f2bf(o[j] * rstd * gn[vv] * g); }
    }
}

constexpr int NA_ATT = 1536, NA_H1 = 1024, NA_CONV = 256, NA_SATT = 64, NA_SCONV = 32, NA_SHG = 128;
constexpr int NA_TOTAL = NA_ATT + NA_H1 + NA_CONV + NA_SATT + NA_SCONV + NA_SHG;
__device__ __forceinline__ void mixerA_phase(const Args& A, const Ctx& C, int l, LAS unsigned char* lds) {
    for (int it = C.bid; it < NA_TOTAL; it += C.G) {
        int r = it;
#ifndef NO_I1
        if (r < NA_ATT) { attn_item(A, C, r, lds); continue; }
#endif
 r -= NA_ATT;
#ifndef NO_I2
        if (r < NA_H1) { h1_item(A, C, r, lds); continue; }
#endif
 r -= NA_H1;
#ifndef NO_I3
        if (r < NA_CONV) { conv_item(A, C, l, r, lds); continue; }
#endif
 r -= NA_CONV;
#ifndef NO_I4
        if (r < NA_SATT) { attn_sample_item(A, C, l, r, lds); continue; }
#endif
 r -= NA_SATT;
#ifndef NO_I5
        if (r < NA_SCONV) { conv_sample_item(A, C, l, r, lds); continue; }
#endif
 r -= NA_SCONV;
#ifndef NO_I6
        hgrn_sample_item(A, C, l, r, lds);
#endif
    }
    __syncthreads();
}

__device__ __forceinline__ void mixerB_phase(const Args& A, const Ctx& C, int l) {
    int tid_ = C.tid; asm volatile("" : "+v"(tid_));
    const int gt = C.bid * NTHR + tid_, NGT = C.G * NTHR;
    for (int e = gt; e < 8 * 16384; e += NGT) {
        const int bh = e >> 14, vd = e & 16383, d = vd & 127, v = vd >> 7;
        float S = 0.f;
        const float* sl = WSP(float, WS_SL) + (size_t)bh * 128 * 16384 + vd; const float* dc = WSP(float, WS_DC) + (size_t)bh * 128 * 128 + d; bf16_t* sp = WSP(bf16_t, WS_SP) + (size_t)bh * 128 * 16384 + vd;
#pragma unroll 8
        for (int c = 0; c < 128; ++c) { sp[(size_t)c * 16384] = (bf16_t)f2bf(S); S = dc[c * 128] * S + sl[(size_t)c * 16384]; }
        A.out[O_HP + (size_t)(l * 8 + bh) * 16384 + d * 128 + v] = S;
    }
    for (int i = gt; i < MP * 64; i += NGT) {
        const int row = i >> 6, c4 = i & 63, h = c4 >> 4;
        const float l0 = WSP(float, WS_LSE)[(size_t)row * 4 + h], l1 = WSP(float, WS_LSE)[(size_t)(MP + row) * 4 + h], l2 = WSP(float, WS_LSE)[(size_t)(2 * MP + row) * 4 + h];
        const float m = fmaxf(l0, fmaxf(l1, l2)); float w0 = __expf(l0 - m), w1 = __expf(l1 - m), w2 = __expf(l2 - m);
        const float inv = 1.f / (w0 + w1 + w2); w0 *= inv; w1 *= inv; w2 *= inv;
        const f32x4 a = *(const f32x4*)(WSP(float, WS_OP) + (size_t)row * 256 + c4 * 4), bq = *(const f32x4*)(WSP(float, WS_OP) + ((size_t)MP + row) * 256 + c4 * 4), cq = *(const f32x4*)(WSP(float, WS_OP) + ((size_t)2 * MP + row) * 256 + c4 * 4);
        const f32x4 y = a * w0 + bq * w1 + cq * w2;
        u32x2 wv; wv.x = pk2(y.x, y.y); wv.y = pk2(y.z, y.w);
        *(u32x2*)(WSP(bf16_t, WS_Y) + (size_t)row * DM + 256 + c4 * 4) = wv;
    }
}

constexpr int H3_QH = 34816, H3_KH = 52224, H3_QT = 69632, H3_VT = 87040, H3_ST = 105472, H3_P = 140288, H3_RED = 149504;
__device__ __forceinline__ void h3_item(const Args& A, const Ctx& C, int l, int item, LAS unsigned char* lds) {
    const int bh = item >> 7, c = item & 127, b = bh >> 2, h = bh & 3; const size_t row0 = (size_t)b * SEQ + c * 64;
    LAS float* Bc = (LAS float*)(lds + H_BC); LAS float* Tot = (LAS float*)(lds + H_TOT);
    LAS bf16_t* Qh = (LAS bf16_t*)(lds + H3_QH); LAS bf16_t* Kh = (LAS bf16_t*)(lds + H3_KH); LAS bf16_t* Qt = (LAS bf16_t*)(lds + H3_QT);
    LAS bf16_t* VT = (LAS bf16_t*)(lds + H3_VT);
    LAS bf16_t* ST = (LAS bf16_t*)(lds + H3_ST);
    LAS bf16_t* P = (LAS bf16_t*)(lds + H3_P);
    LAS float* red = (LAS float*)(lds + H3_RED);
    int tid = C.tid, w = C.wave; asm volatile("" : "+v"(tid), "+s"(w)); const int lane = tid & 63, fr = lane & 15, fq = lane >> 4;
    __syncthreads();
    chunk_cumsum(WSP(float, WS_LF) + row0 * 512 + h * 128, Bc, Tot, tid);
    for (int i = tid; i < 1024; i += NTHR) { const int s = i >> 4, ch = i & 15, d0 = ch * 8;
        const bf16_t* p = WSP(bf16_t, WS_ZB) + (row0 + s) * ZW + h * 128 + d0;
        const u32x4 qv = *(const u32x4*)(p + ZHQ), kk = *(const u32x4*)(p + ZHK), vv = *(const u32x4*)(p + ZHV);
        const unsigned qw[4] = {qv.x, qv.y, qv.z, qv.w}, kw[4] = {kk.x, kk.y, kk.z, kk.w}, vw[4] = {vv.x, vv.y, vv.z, vv.w};
        float qh[8], kh[8], qt[8];
#pragma unroll
        for (int e = 0; e < 8; ++e) { const int d = d0 + e; const float qf = (e & 1) ? bfhi(qw[e >> 1]) : bflo(qw[e >> 1]); const float kf = (e & 1) ? bfhi(kw[e >> 1]) : bflo(kw[e >> 1]);
            const float bt = Bc[s * 128 + d], bm = Bc[31 * 128 + d];
            qh[e] = qf * __expf(bt - bm); kh[e] = kf * __expf(bm - bt); qt[e] = qf * __expf(bt);
            VT[d * 72 + s] = (bf16_t)((e & 1) ? (vw[e >> 1] >> 16) : (vw[e >> 1] & 0xffffu)); }
        u32x4 o;
        o.x = pk2(qh[0], qh[1]); o.y = pk2(qh[2], qh[3]); o.z = pk2(qh[4], qh[5]); o.w = pk2(qh[6], qh[7]); *(LAS u32x4*)(Qh + s * 136 + d0) = o;
        o.x = pk2(kh[0], kh[1]); o.y = pk2(kh[2], kh[3]); o.z = pk2(kh[4], kh[5]); o.w = pk2(kh[6], kh[7]); *(LAS u32x4*)(Kh + s * 136 + d0) = o;
        o.x = pk2(qt[0], qt[1]); o.y = pk2(qt[2], qt[3]); o.z = pk2(qt[4], qt[5]); o.w = pk2(qt[6], qt[7]); *(LAS u32x4*)(Qt + s * 136 + d0) = o; }
    { const bf16_t* sp = WSP(bf16_t, WS_SP) + (size_t)item * 16384;
      for (int i = tid; i < 2048; i += NTHR) { const int v = i >> 4, ch = i & 15; *(LAS u32x4*)(ST + v * 136 + ch * 8) = *(const u32x4*)(sp + v * 128 + ch * 8); } }
    __syncthreads();
    const int ti = w >> 1;
    {
        const int si0 = 2 * (w & 1);
#pragma unroll
        for (int sj = 0; sj < 2; ++sj) { const int si = si0 + sj; f32x4 a = (f32x4){0.f, 0.f, 0.f, 0.f};
#pragma unroll
            for (int k = 0; k < 4; ++k) { const bf16x8 fa = ldfrag(Qh, 136, 16 * ti, 32 * k, lane), fb = ldfrag(Kh, 136, 16 * si, 32 * k, lane); a = MFMA16(fa, fb, a); }
#pragma unroll
            for (int i = 0; i < 4; ++i) { const int t = 16 * ti + 4 * fq + i, s = 16 * si + fr; const float pv = (s <= t) ? a[i] : 0.f; P[t * 72 + s] = (bf16_t)f2bf(pv); } }
    }
    __syncthreads();
    f32x4 acc[4];
    const int vt0 = 4 * (w & 1);
#pragma unroll
    for (int j = 0; j < 4; ++j) acc[j] = (f32x4){0.f, 0.f, 0.f, 0.f};
#pragma unroll
    for (int k = 0; k < 2; ++k) { const bf16x8 fa = ldfrag(P, 72, 16 * ti, 32 * k, lane);
#pragma unroll
        for (int j = 0; j < 4; ++j) { const bf16x8 fb = ldfrag(VT, 72, 16 * (vt0 + j), 32 * k, lane); acc[j] = MFMA16(fa, fb, acc[j]); } }
#pragma unroll
    for (int k = 0; k < 4; ++k) { const bf16x8 fa = ldfrag(Qt, 136, 16 * ti, 32 * k, lane);
#pragma unroll
        for (int j = 0; j < 4; ++j) { const bf16x8 fb = ldfrag(ST, 136, 16 * (vt0 + j), 32 * k, lane); acc[j] = MFMA16(fa, fb, acc[j]); } }
    float ss[4];
#pragma unroll
    for (int i = 0; i < 4; ++i) { float q = 0.f;
#pragma unroll
        for (int j = 0; j < 4; ++j) q += acc[j][i] * acc[j][i];
        ss[i] = sum16(q); }
    if (fr == 0) {
#pragma unroll
        for (int i = 0; i < 4; ++i) red[(w & 1) * 64 + 16 * ti + 4 * fq + i] = ss[i];
    }
    __syncthreads();
    const float* gn = A.in[17] + l * 128;
#pragma unroll
    for (int i = 0; i < 4; ++i) { const int t = 16 * ti + 4 * fq + i; const float rstd = 1.0f / sqrtf((red[t] + red[64 + t]) * (1.f / 128.f) + EPS);
        const size_t row = row0 + t;
#pragma unroll
        for (int j = 0; j < 4; ++j) { const int v = 16 * (vt0 + j) + fr; const float g = bf2f(WSP(bf16_t, WS_ZB)[row * ZW + ZHG + h * 128 + v]);
            WSP(bf16_t, WS_Y)[row * DM + 512 + h * 128 + v] = (bf16_t)f2bf(acc[j][i] * rstd * gn[v] * g); } }
}

__global__ void __launch_bounds__(NTHR, 2) fwd_megakernel(Args args) {
    extern __shared__ __attribute__((aligned(16))) unsigned char lds_raw[];
    cg::grid_group grid = cg::this_grid();
    LAS unsigned char* lds = (LAS unsigned char*)lds_raw;
    const Args& A = args;
    Ctx C;
    C.tid = threadIdx.x; C.lane = C.tid & 63; C.wave = __builtin_amdgcn_readfirstlane(C.tid >> 6); C.G = gridDim.x; C.bid = blockIdx.x;

#ifndef NO_PRO
    prologue_phase(A, C, lds);
#endif
    grid.sync();
#pragma unroll 1
    for (int l = 0; l < DEPTH; ++l) {
#pragma unroll 1
        for (int f = 0; f < 2; ++f) {
            if (f == 1) {
                norm_phase<0>(A, C, A.in[10] + l * DM);
                grid.sync();
                {
                    pg8::Gemm g{WSP(bf16_t, WS_XN), (const bf16_t*)(A.ws + WS_WIN + (size_t)l * SZ_WIN), MPAD, NIN, DM}; pg8::StaticOrder S; S.init(MPAD, NIN, C.G, C.bid);
                    EpiWin E{WSP(bf16_t, WS_ZB), WSP(float, WS_LF), WSP(float, WS_LB) + l * 512, A.out + O_KP + (size_t)l * 2 * 2048 * 256, A.out + O_VP + (size_t)l * 2 * 2048 * 256,
                             A.out + O_KS + (size_t)l * MS * 256, A.out + O_VS + (size_t)l * MS * 256};

#ifndef NO_GWIN
 pg8::gemm_phase<EpiWin, pg8::StaticOrder, true, true>(lds, g, S, E);
#endif

                }
                grid.sync();
#ifndef NO_MA
                mixerA_phase(A, C, l, lds);
#endif
                grid.sync();
#ifndef NO_MB
                mixerB_phase(A, C, l);
#endif
                grid.sync();
#ifndef NO_MC
                for (int it = C.bid; it < 1024; it += C.G) h3_item(A, C, l, it, lds);
#endif
                __syncthreads();
                grid.sync();
                {
                    pg8::Gemm g{WSP(bf16_t, WS_Y), (const bf16_t*)(A.ws + WS_WO + (size_t)l * SZ_WO), MPAD, DM, DM}; pg8::StaticOrder S; S.init(MPAD, DM, C.G, C.bid);
                    EpiResid E{WSP(float, WS_X)};

#ifndef NO_GRES
 pg8::gemm_phase<EpiResid, pg8::StaticOrder, true, true>(lds, g, S, E);
#endif

                }
                grid.sync();
                norm_phase<0>(A, C, A.in[19] + l * DM);
                grid.sync();
            }
            {
                pg8::Gemm g{WSP(bf16_t, WS_XN), (const bf16_t*)(A.ws + WS_WGU + (size_t)(l * 2 + f) * SZ_WGU), MPAD, 2 * FF, DM}; pg8::StaticOrder S; S.init(MPAD, 2 * FF, C.G, C.bid);
                EpiSwiglu E{WSP(bf16_t, WS_ACT)};

#ifndef NO_GSW
 pg8::gemm_phase<EpiSwiglu, pg8::StaticOrder, true, true>(lds, g, S, E);
#endif

            }
            grid.sync();
            {
                pg8::Gemm g{WSP(bf16_t, WS_ACT), (const bf16_t*)(A.ws + WS_WD + (size_t)(l * 2 + f) * SZ_WD), MPAD, DM, FF}; pg8::StaticOrder S; S.init(MPAD, DM, C.G, C.bid);
                EpiResid E{WSP(float, WS_X)};

#ifndef NO_GRES
 pg8::gemm_phase<EpiResid, pg8::StaticOrder, true, true>(lds, g, S, E);
#endif

            }
            grid.sync();
        }
        if (l + 1 < DEPTH) { norm_phase<0>(A, C, A.in[6] + (l + 1) * DM); grid.sync(); }
    }
    norm_phase<2>(A, C, A.in[23]);
}

extern "C" void kernel_launch(void* const* d_in, const int* in_sizes, int n_in, void* d_out, int out_size, void* d_ws, size_t ws_size, hipStream_t stream) {
    static int grid = 0;
    if (grid == 0) {
        if (n_in != 24 || (size_t)out_size != O_END || ws_size < WS_END) { fprintf(stderr, "kernel_launch: unexpected shapes: n_in %d out %d ws %zu (need %zu)\n", n_in, out_size, ws_size, (size_t)WS_END); grid = -1; return; }
        int dev = 0, cus = 0, per_cu = 0;
        hipGetDevice(&dev);
        hipDeviceGetAttribute(&cus, hipDeviceAttributeMultiprocessorCount, dev);
        if (hipFuncSetAttribute((const void*)fwd_megakernel, hipFuncAttributeMaxDynamicSharedMemorySize, LDS_BYTES) != hipSuccess) { fprintf(stderr, "kernel_launch: hipFuncSetAttribute failed\n"); grid = -1; return; }
        hipOccupancyMaxActiveBlocksPerMultiprocessor(&per_cu, (const void*)fwd_megakernel, NTHR, LDS_BYTES);
        if (per_cu < 1) { fprintf(stderr, "kernel_launch: occupancy query says %d blocks/CU\n", per_cu); per_cu = 1; }
        (void)hipGetLastError();
        grid = cus;
    }
    if (grid < 0) return;
    Args a{};
    for (int i = 0; i < 24; ++i) a.in[i] = (const float*)d_in[i];
    a.out = (float*)d_out; a.ws = (unsigned char*)d_ws;
    void* kargs[] = {&a};
    hipError_t e = hipLaunchCooperativeKernel((const void*)fwd_megakernel, dim3(grid), dim3(NTHR), kargs, LDS_BYTES, stream);
    if (e != hipSuccess) fprintf(stderr, "cooperative launch failed: %s (grid %d)\n", hipGetErrorString(e), grid);
}
```

```cpp
#include <hip/hip_runtime.h>
#include <hip/hip_cooperative_groups.h>
#include <cstdio>
#include <cstdint>
namespace cg = cooperative_groups;
namespace pg8 {
#define PG8_LAS __attribute__((address_space(3)))
typedef unsigned short bf16_t;
typedef short bf16x8 __attribute__((ext_vector_type(8)));
typedef float f32x4 __attribute__((ext_vector_type(4)));
typedef unsigned u32x4 __attribute__((ext_vector_type(4)));
constexpr int BM = 256, BK = 64, HALF = 128, HTB = HALF * BK * 2  , STAGE_BYTES = 8 * HTB, NXCD = 8, WGM = 8;

__host__ __device__ __forceinline__ int lds_byte(int r, int c) { const int st = (r >> 4) * 2 + (c >> 5), rr = r & 15, cc = c & 31, ob = rr * 64 + cc * 2; return st * 1024 + (ob ^ (((ob >> 9) & 1) << 5)); }
__host__ __device__ __forceinline__ void stage_rc(int b, int& R, int& C) { const int st = b / 1024, sb = b % 1024, swz = sb ^ (((sb >> 9) & 1) << 5); R = (st >> 1) * 16 + swz / 64; C = (st & 1) * 32 + (swz % 64) / 2; }
__host__ __device__ __forceinline__ int perm32(int rho) { const int n = rho >> 4, i = rho & 15; return 8 * (i >> 2) + 4 * n + (i & 3); }

struct Unit { int pm, pn, kt0, nt; };
struct Gemm { const bf16_t* A; const bf16_t* Bt; int M, N, K; };

struct StaticOrder {
    int nM, nN, nwg, G, c, ntk;
    __host__ __device__ __forceinline__ void init(int M, int N, int G_, int c_, int K_) { nM = M / BM; nN = N / BM; nwg = nM * nN; G = G_; c = c_; ntk = K_ / BK; }
    __host__ __device__ __forceinline__ void map(long L, int& pm, int& pn) const {
        int wgid = (int)L; { const int q = nwg / NXCD, r = nwg % NXCD, xcd = wgid % NXCD, off = wgid / NXCD; wgid = (xcd < r ? xcd * (q + 1) : r * (q + 1) + (xcd - r) * q) + off; }
        const int nig = WGM * nN, gid = wgid / nig, fm = gid * WGM, gsz = (nM - fm) < WGM ? (nM - fm) : WGM;
        pm = fm + ((wgid % nig) % gsz); pn = (wgid % nig) / gsz;
    }
    __host__ __device__ __forceinline__ bool next(int i, Unit& u) const {
        const long L = (long)i * G + c; const bool ok = L < nwg; int pm, pn; map(ok ? L : 0, pm, pn);
        u.pm = pm; u.pn = pn; u.kt0 = 0; u.nt = ntk; return ok;
    }
    __device__ __forceinline__ void a_ready(const Unit&) const {}
    __device__ __forceinline__ void done(const Unit&) const {}
};

struct SplitOrder {
    StaticOrder P; int nsplit;
    __host__ __device__ __forceinline__ void init(int Mp, int N, int G_, int c_, int K_, int nsplit_) { P.init(Mp, N, G_, c_, K_); nsplit = nsplit_; }
    __host__ __device__ __forceinline__ bool next(int i, Unit& u) const {
        const long L = (long)i * P.G + P.c; const bool samp = L >= P.nwg; const int j = samp ? (int)(L - P.nwg) : 0;
        int pm, pn; P.map(samp ? 0 : L, pm, pn);
        const int nts = P.ntk / nsplit;
        u.pm = samp ? P.nM : pm; u.pn = samp ? (j % P.nN) : pn; u.nt = samp ? nts : P.ntk; u.kt0 = samp ? (j / P.nN) * nts : 0;
        return L < (long)P.nwg + P.nN * nsplit;
    }
    __device__ __forceinline__ void a_ready(const Unit&) const {}
    __device__ __forceinline__ void done(const Unit&) const {}
};

__device__ __forceinline__ unsigned cvt_pk_bf16(float lo, float hi) { unsigned r; asm volatile("v_cvt_pk_bf16_f32 %0, %1, %2" : "=v"(r) : "v"(lo), "v"(hi)); return r; }
template <class Epi, class Sched, bool ALIGN_EPI = false, bool SP2 = false>
__device__ __forceinline__ void gemm_phase(PG8_LAS unsigned char* lds, const Gemm g, const Sched& S, const Epi& E) {
    int tid_ = threadIdx.x; asm volatile("" : "+v"(tid_));
    const int tid = tid_, wid = __builtin_amdgcn_readfirstlane(tid >> 6), lane = tid & 63, wr = wid >> 2, wc = wid & 3, fr = lane & 15, fq = lane >> 4;
    const int K = g.K;
    unsigned voffA[2], voffB[2];
#pragma unroll
    for (int i = 0; i < 2; ++i) { int R, C; stage_rc(tid * 16 + i * 8192, R, C); const int Rb = Epi::PERM ? ((R & ~31) + perm32(R & 31)) : R;
        voffA[i] = (unsigned)(R * K + C) * 2u; voffB[i] = (unsigned)(Rb * K + C) * 2u; }
    const size_t kstep = (size_t)(BK * 2);
    const size_t hstep = (size_t)HALF * K * 2;
    const size_t tstep = 2 * hstep;
    const unsigned ldsw = (unsigned)wid * 1024u;
    const int aoff = lds_byte(wr * 64 + fr, fq * 8), boff = lds_byte(wc * 32 + fr, fq * 8);
#define PG8_SA(b, h) (((b) * 2 + (h)) * HTB)
#define PG8_SB(b, h) ((4 + (b) * 2 + (h)) * HTB)
#define PG8_STAGE(bufoff, gbase, voff) do { _Pragma("unroll") for (int _i = 0; _i < 2; ++_i) \
        __builtin_amdgcn_global_load_lds((const unsigned*)((const char*)(gbase) + (voff)[_i]), (PG8_LAS unsigned*)(lds + (bufoff) + ldsw + _i * 8192), 16, 0, 0); } while (0)
#define PG8_LDA(dst, b, h) do { _Pragma("unroll") for (int m = 0; m < 4; ++m) _Pragma("unroll") for (int k = 0; k < 2; ++k) dst[m][k] = *(const PG8_LAS bf16x8*)(lds + PG8_SA(b, h) + aoff + m * 2048 + k * 1024); } while (0)
#define PG8_LDB(dst, b, h) do { _Pragma("unroll") for (int n = 0; n < 2; ++n) _Pragma("unroll") for (int k = 0; k < 2; ++k) dst[n][k] = *(const PG8_LAS bf16x8*)(lds + PG8_SB(b, h) + boff + n * 2048 + k * 1024); } while (0)
#define PG8_MMA(ai, bj, At, Bt) do { __builtin_amdgcn_s_setprio(1); _Pragma("unroll") for (int m = 0; m < 4; ++m) _Pragma("unroll") for (int n = 0; n < 2; ++n) _Pragma("unroll") for (int k = 0; k < 2; ++k) \
        acc[ai][bj][m][n] = __builtin_amdgcn_mfma_f32_16x16x32_bf16(Bt[n][k], At[m][k], acc[ai][bj][m][n], 0, 0, 0); __builtin_amdgcn_s_setprio(0); } while (0)
#define PG8_WAIT_V(n) asm volatile("s_waitcnt vmcnt(" #n ")" ::: "memory")
#define PG8_WAIT_L(n) asm volatile("s_waitcnt lgkmcnt(" #n ")" ::: "memory")
#define PG8_BAR __builtin_amdgcn_s_barrier()
#define PG8_SCHED __builtin_amdgcn_sched_barrier(0)
    Unit cur, nxt; int ui = 0;
    if (!S.next(0, cur)) return;
    f32x4 acc[2][2][4][2];
#pragma unroll
    for (int a = 0; a < 2; ++a)
#pragma unroll
        for (int b = 0; b < 2; ++b)
#pragma unroll
            for (int m = 0; m < 4; ++m)
#pragma unroll
                for (int n = 0; n < 2; ++n) acc[a][b][m][n] = (f32x4){0.f, 0.f, 0.f, 0.f};
    bf16x8 At[4][2], B0[2][2], B1[2][2];
    const char* cA = (const char*)g.A + (size_t)cur.pm * tstep + (size_t)cur.kt0 * kstep; const char* cB = (const char*)g.Bt + (size_t)cur.pn * tstep + (size_t)cur.kt0 * kstep;
    S.a_ready(cur);
    if constexpr (SP2) {
        PG8_STAGE(PG8_SB(0, 0), cB, voffB); PG8_STAGE(PG8_SB(0, 1), cB + hstep, voffB); PG8_STAGE(PG8_SA(0, 0), cA, voffA); PG8_STAGE(PG8_SA(0, 1), cA + hstep, voffA);
        if (wr == 1) PG8_BAR;
        PG8_WAIT_V(2); PG8_BAR;
        PG8_STAGE(PG8_SB(1, 0), cB + kstep, voffB); PG8_STAGE(PG8_SA(1, 0), cA + kstep, voffA); PG8_STAGE(PG8_SB(1, 1), cB + hstep + kstep, voffB);
        PG8_WAIT_V(6); PG8_BAR;
    } else {
        PG8_STAGE(PG8_SB(0, 0), cB, voffB); PG8_STAGE(PG8_SA(0, 0), cA, voffA); PG8_STAGE(PG8_SB(0, 1), cB + hstep, voffB); PG8_STAGE(PG8_SA(0, 1), cA + hstep, voffA);
        if (wr == 1) PG8_BAR;
        PG8_WAIT_V(4); PG8_BAR;
        PG8_STAGE(PG8_SB(1, 0), cB + kstep, voffB); PG8_STAGE(PG8_SA(1, 0), cA + kstep, voffA); PG8_STAGE(PG8_SB(1, 1), cB + hstep + kstep, voffB);
        PG8_WAIT_V(6); PG8_BAR;
    }
    for (;;) {
        const bool has_next = S.next(ui + 1, nxt);
        const char* nA = has_next ? (const char*)g.A + (size_t)nxt.pm * tstep + (size_t)nxt.kt0 * kstep : cA; const char* nB = has_next ? (const char*)g.Bt + (size_t)nxt.pn * tstep + (size_t)nxt.kt0 * kstep : cB;
        const int nt = cur.nt;
        for (int t = 0; t < nt; t += 2) {
            const bool last = (t == nt - 2);
            const char* a1 = cA + (size_t)(t + 1) * kstep;
            const char* a2 = last ? nA : cA + (size_t)(t + 2) * kstep; const char* b2 = last ? nB : cB + (size_t)(t + 2) * kstep;
            const char* a3 = a2 + kstep; const char* b3 = b2 + kstep;
            if (last && has_next) S.a_ready(nxt);
            if constexpr (SP2) {
            PG8_LDB(B0, 0, 0); PG8_LDB(B1, 0, 1); PG8_SCHED; PG8_LDA(At, 0, 0); PG8_STAGE(PG8_SA(1, 1), a1 + hstep, voffA);
            PG8_WAIT_V(8); PG8_WAIT_L(0); PG8_BAR; PG8_MMA(0, 0, At, B0); PG8_MMA(0, 1, At, B1); PG8_BAR; PG8_SCHED;
            PG8_LDA(At, 0, 1); PG8_STAGE(PG8_SB(0, 0), b2, voffB); PG8_STAGE(PG8_SB(0, 1), b2 + hstep, voffB); PG8_STAGE(PG8_SA(0, 0), a2, voffA);
            PG8_WAIT_V(8); PG8_WAIT_L(0); PG8_BAR; PG8_MMA(1, 0, At, B0); PG8_MMA(1, 1, At, B1); PG8_BAR; PG8_SCHED;
            PG8_LDB(B0, 1, 0); PG8_LDB(B1, 1, 1); PG8_SCHED; PG8_LDA(At, 1, 0); PG8_STAGE(PG8_SA(0, 1), a2 + hstep, voffA);
            PG8_WAIT_V(8); PG8_WAIT_L(0); PG8_BAR; PG8_MMA(0, 0, At, B0); PG8_MMA(0, 1, At, B1); PG8_BAR; PG8_SCHED;
            PG8_LDA(At, 1, 1); PG8_STAGE(PG8_SB(1, 0), b3, voffB); PG8_STAGE(PG8_SB(1, 1), b3 + hstep, voffB); PG8_STAGE(PG8_SA(1, 0), a3, voffA);
            PG8_WAIT_V(8); PG8_WAIT_L(0); PG8_BAR; PG8_MMA(1, 0, At, B0); PG8_MMA(1, 1, At, B1); PG8_BAR; PG8_SCHED;
            } else {
            PG8_LDB(B0, 0, 0); PG8_SCHED; PG8_LDA(At, 0, 0); PG8_STAGE(PG8_SA(1, 1), a1 + hstep, voffA);
            PG8_WAIT_L(8); PG8_BAR; PG8_WAIT_L(0); PG8_MMA(0, 0, At, B0); PG8_BAR; PG8_SCHED;
            PG8_LDB(B1, 0, 1); PG8_STAGE(PG8_SB(0, 0), b2, voffB);
            PG8_BAR; PG8_WAIT_L(0); PG8_MMA(0, 1, At, B1); PG8_BAR;
            PG8_LDA(At, 0, 1); PG8_STAGE(PG8_SA(0, 0), a2, voffA);
            PG8_BAR; PG8_WAIT_L(0); PG8_MMA(1, 0, At, B0); PG8_BAR; PG8_SCHED;
            PG8_STAGE(PG8_SB(0, 1), b2 + hstep, voffB);
            PG8_WAIT_V(6); PG8_BAR; PG8_MMA(1, 1, At, B1); PG8_BAR;
            PG8_LDB(B0, 1, 0); PG8_SCHED; PG8_LDA(At, 1, 0); PG8_STAGE(PG8_SA(0, 1), a2 + hstep, voffA);
            PG8_WAIT_L(8); PG8_BAR; PG8_WAIT_L(0); PG8_MMA(0, 0, At, B0); PG8_BAR; PG8_SCHED;
            PG8_LDB(B1, 1, 1); PG8_STAGE(PG8_SB(1, 0), b3, voffB);
            PG8_BAR; PG8_WAIT_L(0); PG8_MMA(0, 1, At, B1); PG8_BAR;
            PG8_LDA(At, 1, 1); PG8_STAGE(PG8_SA(1, 0), a3, voffA);
            PG8_BAR; PG8_WAIT_L(0); PG8_MMA(1, 0, At, B0); PG8_BAR; PG8_SCHED;
            PG8_STAGE(PG8_SB(1, 1), b3 + hstep, voffB);
            PG8_WAIT_V(6); PG8_BAR; PG8_MMA(1, 1, At, B1); PG8_BAR;
            }
        }
        if constexpr (ALIGN_EPI) { if (wr == 0) PG8_BAR; }
        if constexpr (!Epi::AFTER_DRAIN) { E(acc, cur, wr, wc, fr, fq); S.done(cur); }
        if (!has_next) break;
#pragma unroll
        for (int a = 0; a < 2; ++a)
#pragma unroll
            for (int b = 0; b < 2; ++b)
#pragma unroll
                for (int m = 0; m < 4; ++m)
#pragma unroll
                    for (int n = 0; n < 2; ++n) acc[a][b][m][n] = (f32x4){0.f, 0.f, 0.f, 0.f};
        cur = nxt; cA = nA; cB = nB; ++ui;
        if constexpr (ALIGN_EPI) { if (wr == 1) PG8_BAR; }
    }
    PG8_WAIT_V(0);
    if constexpr (!ALIGN_EPI) { if (wr == 0) PG8_BAR; }
    PG8_BAR;
    if constexpr (Epi::AFTER_DRAIN) { E.fused(acc, cur, wr, wc, fr, fq, lds, wid, lane); S.done(cur); }
#undef PG8_SA
#undef PG8_SB
#undef PG8_STAGE
#undef PG8_LDA
#undef PG8_LDB
#undef PG8_MMA
#undef PG8_WAIT_V
#undef PG8_WAIT_L
#undef PG8_BAR
#undef PG8_SCHED
}
}

#define LAS __attribute__((address_space(3)))
typedef unsigned short bf16_t;
typedef short bf16x8 __attribute__((ext_vector_type(8)));
typedef float f32x4 __attribute__((ext_vector_type(4)));
typedef unsigned u32x4 __attribute__((ext_vector_type(4)));
typedef unsigned u32x2 __attribute__((ext_vector_type(2)));

constexpr int DM = 1024, SEQ = 8192, NB = 2, DEPTH = 4, DB = 32, DS = 4;
constexpr int MP = NB * SEQ;
constexpr int MS = DB * DS;
constexpr int MR = MP + MS;
constexpr int MPAD = 16640;
constexpr int FF = 2816, NIN = 3328, ZW = 3072;
constexpr int ZQ = 256, ZK = 512, ZV = 768, ZHQ = 1024, ZHK = 1536, ZHV = 2048, ZHG = 2560;
constexpr float EPS = 1e-6f;
constexpr int NTHR = 512;
constexpr int LDS_BYTES = 151552;

constexpr size_t al256(size_t x) { return (x + 255) & ~(size_t)255; }
constexpr size_t SZ_WGU = (size_t)2 * FF * DM * 2, SZ_WD = (size_t)DM * FF * 2, SZ_WIN = (size_t)NIN * DM * 2, SZ_WO = (size_t)DM * DM * 2;
constexpr size_t WS_WGU = 0;
constexpr size_t WS_WD = WS_WGU + 8 * SZ_WGU;
constexpr size_t WS_WIN = WS_WD + 8 * SZ_WD;
constexpr size_t WS_WO = WS_WIN + 4 * SZ_WIN;
constexpr size_t WS_LB = WS_WO + 4 * SZ_WO;
constexpr size_t WS_X = al256(WS_LB + 4 * 512 * 4);
constexpr size_t WS_XN = WS_X + (size_t)MPAD * DM * 4;
constexpr size_t WS_ACT = WS_XN + (size_t)MPAD * DM * 2;
constexpr size_t WS_ZB = WS_ACT + (size_t)MPAD * FF * 2;
constexpr size_t WS_LF = WS_ZB + (size_t)MPAD * ZW * 2;
constexpr size_t WS_Y = WS_LF + (size_t)MPAD * 512 * 4;
constexpr size_t WS_OP = WS_Y + (size_t)MPAD * DM * 2;
constexpr size_t WS_LSE = WS_OP + (size_t)3 * MP * 256 * 4;
constexpr size_t WS_SL = WS_LSE + (size_t)3 * MP * 4 * 4;
constexpr size_t WS_SP = WS_SL + (size_t)1024 * 16384 * 4;
constexpr size_t WS_DC = WS_SP + (size_t)1024 * 16384 * 2;
constexpr size_t WS_BAR = WS_DC + (size_t)1024 * 128 * 4;
constexpr size_t WS_BAR_BYTES = 16384;
constexpr size_t WS_END = WS_BAR + WS_BAR_BYTES;

constexpr size_t O_YP = 0, O_YS = 16777216, O_CP = O_YS + 131072, O_CS = O_CP + 61440, O_KP = O_CS + 983040, O_VP = O_KP + 4194304,
                 O_KS = O_VP + 4194304, O_VS = O_KS + 131072, O_HP = O_VS + 131072, O_HS = O_HP + 524288, O_END = O_HS + 8388608;

struct Args {
    const float* in[24];
    float* out;
    unsigned char* ws;
};

struct Ctx { int tid, wave, G, bid; };
extern __shared__ __attribute__((aligned(16))) unsigned char lds_raw[];
constexpr int PT_OFF = 150528;
__device__ __forceinline__ unsigned long long ptab_ld(int k) {
    const unsigned long long v = ((const LAS unsigned long long*)((LAS unsigned char*)lds_raw + PT_OFF))[k];
    const unsigned lo = __builtin_amdgcn_readfirstlane((unsigned)v), hi = __builtin_amdgcn_readfirstlane((unsigned)(v >> 32));
    return ((unsigned long long)hi << 32) | lo;
}
#define GAS1 __attribute__((address_space(1)))
#define PIN(k) ((const float*)(const GAS1 float*)ptab_ld(k))
#define POUT ((float*)(GAS1 float*)ptab_ld(24))
#define PWS ((unsigned char*)(GAS1 unsigned char*)ptab_ld(25))
#define WSP(T, off) ((T*)(PWS + (off)))

__device__ __forceinline__ unsigned f2bf(float f) { unsigned u = __builtin_bit_cast(unsigned, f); return (u + 0x7fffu + ((u >> 16) & 1u)) >> 16; }
__device__ __forceinline__ unsigned pk2(float lo, float hi) { return f2bf(lo) | (f2bf(hi) << 16); }
__device__ __forceinline__ float bf2f(unsigned h) { return __builtin_bit_cast(float, (h & 0xffffu) << 16); }
__device__ __forceinline__ float bflo(unsigned w) { return __builtin_bit_cast(float, w << 16); }
__device__ __forceinline__ float bfhi(unsigned w) { return __builtin_bit_cast(float, w & 0xffff0000u); }
__device__ __forceinline__ float sigmoidf_(float x) { return __builtin_amdgcn_rcpf(1.f + __expf(-x)); }
__device__ __forceinline__ float siluf_(float x) { return x * sigmoidf_(x); }
__device__ __forceinline__ float wave_sum(float v) {
#pragma unroll
    for (int o = 1; o < 64; o <<= 1) v += __shfl_xor(v, o);
    return v;
}
__device__ __forceinline__ float wave_max(float v) {
#pragma unroll
    for (int o = 1; o < 64; o <<= 1) v = fmaxf(v, __shfl_xor(v, o));
    return v;
}
__device__ __forceinline__ float sum16(float v) { v += __shfl_xor(v, 1); v += __shfl_xor(v, 2); v += __shfl_xor(v, 4); v += __shfl_xor(v, 8); return v; }
__device__ __forceinline__ float max16(float v) { v = fmaxf(v, __shfl_xor(v, 1)); v = fmaxf(v, __shfl_xor(v, 2)); v = fmaxf(v, __shfl_xor(v, 4)); v = fmaxf(v, __shfl_xor(v, 8)); return v; }
__device__ __forceinline__ bf16x8 ldfrag(const LAS bf16_t* base, int ld, int r0, int k0, int lane) {
    return *(const LAS bf16x8*)(base + (r0 + (lane & 15)) * ld + k0 + 8 * (lane >> 4));
}
#define MFMA16(a, b, c) __builtin_amdgcn_mfma_f32_16x16x32_bf16((a), (b), (c), 0, 0, 0)
#define LDS_FENCE() asm volatile("s_waitcnt lgkmcnt(0)" ::: "memory")

struct EpiSwiglu {
    static constexpr bool PERM = true, AFTER_DRAIN = false;
    bf16_t* O;
    __device__ __forceinline__ void operator()(const f32x4 (&acc)[2][2][4][2], const pg8::Unit& u_, int wr, int wc_, int fr_, int fq_) const {
        pg8::Unit u = u_; int wc = wc_, fr = fr_, fq = fq_; asm volatile("" : "+s"(u.pm), "+s"(u.pn), "+v"(fr), "+v"(fq), "+s"(wc));
        const int row0 = u.pm * 256 + wr * 64 + fr, col0 = u.pn * 128 + wc * 32 + 8 * fq;
#pragma unroll
        for (int ai = 0; ai < 2; ++ai)
#pragma unroll
            for (int m = 0; m < 4; ++m) {
                bf16_t* rowp = O + (size_t)(row0 + ai * 128 + m * 16) * FF + col0;
                float v[8];
#pragma unroll
                for (int n = 0; n < 2; ++n)
#pragma unroll
                    for (int i = 0; i < 4; ++i) v[n * 4 + i] = siluf_(acc[ai][0][m][n][i]) * acc[ai][1][m][n][i];
                u32x4 w; w.x = pk2(v[0], v[1]); w.y = pk2(v[2], v[3]); w.z = pk2(v[4], v[5]); w.w = pk2(v[6], v[7]);
                *(u32x4*)rowp = w;
            }
    }
};
struct EpiResid {
    static constexpr bool PERM = false, AFTER_DRAIN = false;
    float* X; float* P;
    __device__ __forceinline__ void operator()(const f32x4 (&acc)[2][2][4][2], const pg8::Unit& u_, int wr, int wc_, int fr_, int fq_) const {
        pg8::Unit u = u_; int wc = wc_, fr = fr_, fq = fq_; asm volatile("" : "+s"(u.pm), "+s"(u.pn), "+v"(fr), "+v"(fq), "+s"(wc));
        const int row0 = u.pm * 256 + wr * 64 + fr, col0 = u.pn * 256 + wc * 32 + 4 * fq;
        if (u.pm == MP / 256) {
            float* Pb = P + (size_t)(u.kt0 / u.nt) * 128 * DM;
#pragma unroll
            for (int m = 0; m < 4; ++m) {
                float* p = Pb + (size_t)(wr * 64 + m * 16 + fr) * DM + col0;
#pragma unroll
                for (int bj = 0; bj < 2; ++bj)
#pragma unroll
                    for (int n = 0; n < 2; ++n) *(f32x4*)(p + bj * 128 + n * 16) = acc[0][bj][m][n];
            }
            return;
        }
#pragma unroll
        for (int ai = 0; ai < 2; ++ai)
#pragma unroll
            for (int m = 0; m < 4; ++m) {
                float* p = X + (size_t)(row0 + ai * 128 + m * 16) * DM + col0;
                f32x4 t[2][2];
#pragma unroll
                for (int bj = 0; bj < 2; ++bj)
#pragma unroll
                    for (int n = 0; n < 2; ++n) t[bj][n] = *(const f32x4*)(p + bj * 128 + n * 16);
#pragma unroll
                for (int bj = 0; bj < 2; ++bj)
#pragma unroll
                    for (int n = 0; n < 2; ++n) *(f32x4*)(p + bj * 128 + n * 16) = t[bj][n] + acc[ai][bj][m][n];
                if (m == 3) asm volatile("" ::: "memory");
            }
    }
};
struct EpiWin {
    static constexpr bool PERM = true, AFTER_DRAIN = false;
    bf16_t* ZB; float* LF; const float* LB  ; float* outK; float* outV; float* outKs; float* outVs;
    __device__ __forceinline__ void operator()(const f32x4 (&acc)[2][2][4][2], const pg8::Unit& u_, int wr, int wc_, int fr_, int fq_) const {
        pg8::Unit u = u_; int wc = wc_, fr = fr_, fq = fq_; asm volatile("" : "+s"(u.pm), "+s"(u.pn), "+v"(fr), "+v"(fq), "+s"(wc));
        const int row0 = u.pm * 256 + wr * 64 + fr; const int pn = u.pn; const int cw = wc * 32 + 8 * fq;
        if (pn < 2) {
#pragma unroll
            for (int ai = 0; ai < 2; ++ai)
#pragma unroll
                for (int m = 0; m < 4; ++m) {
                    const int row = row0 + ai * 128 + m * 16; float v[8];
#pragma unroll
                    for (int n = 0; n < 2; ++n)
#pragma unroll
                        for (int i = 0; i < 4; ++i) v[n * 4 + i] = acc[ai][0][m][n][i] * sigmoidf_(acc[ai][1][m][n][i]);
                    u32x4 w; w.x = pk2(v[0], v[1]); w.y = pk2(v[2], v[3]); w.z = pk2(v[4], v[5]); w.w = pk2(v[6], v[7]);
                    *(u32x4*)(ZB + (size_t)row * ZW + pn * 128 + cw) = w;
                }
            return;
        }
        int zcol; int kind;
        if (pn == 2) { zcol = ZQ; kind = 0; } else if (pn == 3) { zcol = ZK; kind = 1; } else if (pn == 4) { zcol = ZV; kind = 2; }
        else if (pn < 7) { zcol = ZHQ + (pn - 5) * 256; kind = 3; } else if (pn < 9) { zcol = ZHK + (pn - 7) * 256; kind = 4; }
        else if (pn < 11) { zcol = ZHV + (pn - 9) * 256; kind = 5; } else { zcol = ZHG + (pn - 11) * 256; kind = 3; }
#pragma unroll
        for (int bj = 0; bj < 2; ++bj) {
            const int cin = bj * 128 + cw;
            float lb[8];
            if (kind == 4) {
#pragma unroll
                for (int i = 0; i < 8; ++i) lb[i] = LB[(pn - 7) * 256 + cin + i];
            }
#pragma unroll
            for (int ai = 0; ai < 2; ++ai)
#pragma unroll
                for (int m = 0; m < 4; ++m) {
                    const int row = row0 + ai * 128 + m * 16; float v[8];
#pragma unroll
                    for (int n = 0; n < 2; ++n)
#pragma unroll
                        for (int i = 0; i < 4; ++i) v[n * 4 + i] = acc[ai][bj][m][n][i];
                    if (kind == 1 || kind == 2) {
                        float* dst = nullptr;
                        if (row < MP) { const int b = row >> 13, t = row & (SEQ - 1); if (t >= SEQ - 2048) dst = (kind == 1 ? outK : outV) + ((size_t)(b * 2048 + (t - (SEQ - 2048))) * 256 + cin); }
                        else if (row < MR) dst = (kind == 1 ? outKs : outVs) + ((size_t)(row - MP) * 256 + cin);
                        if (dst) { *(f32x4*)dst = (f32x4){v[0], v[1], v[2], v[3]}; *(f32x4*)(dst + 4) = (f32x4){v[4], v[5], v[6], v[7]}; }
                    }
                    if (kind == 0) {
#pragma unroll
                        for (int i = 0; i < 8; ++i) v[i] *= 0.125f;
                    } else if (kind == 3) {
#pragma unroll
                        for (int i = 0; i < 8; ++i) v[i] = siluf_(v[i]);
                    } else if (kind == 4) {
                        float lf[8];
#pragma unroll
                        for (int i = 0; i < 8; ++i) { const float sg = sigmoidf_(v[i]); const float f = lb[i] + (1.f - lb[i]) * sg; lf[i] = __logf(f); v[i] = (1.f - lb[i]) * sigmoidf_(-v[i]); }
                        float* lp = LF + (size_t)row * 512 + (pn - 7) * 256 + cin;
                        *(f32x4*)lp = (f32x4){lf[0], lf[1], lf[2], lf[3]}; *(f32x4*)(lp + 4) = (f32x4){lf[4], lf[5], lf[6], lf[7]};
                    }
                    u32x4 w; w.x = pk2(v[0], v[1]); w.y = pk2(v[2], v[3]); w.z = pk2(v[4], v[5]); w.w = pk2(v[6], v[7]);
                    *(u32x4*)(ZB + (size_t)row * ZW + zcol + cin) = w;
                }
        }
    }
};

__device__ __forceinline__ void transpose_item(const float* W, int K, int N, int k0, int n0, bf16_t* dst, LAS float* scr, int lane, float wscale = 1.0f) {
#pragma unroll 8
    for (int i = 0; i < 32; ++i) { const int kk = 2 * i + (lane >> 5); scr[kk * 33 + (lane & 31)] = wscale * W[(size_t)(k0 + kk) * N + n0 + (lane & 31)]; }
    LDS_FENCE();
    const int c = lane & 7;
#pragma unroll
    for (int j = 0; j < 4; ++j) { const int n = (lane >> 3) + 8 * j; const LAS float* s = scr + (8 * c) * 33 + n;
        u32x4 o; o.x = pk2(s[0 * 33], s[1 * 33]); o.y = pk2(s[2 * 33], s[3 * 33]); o.z = pk2(s[4 * 33], s[5 * 33]); o.w = pk2(s[6 * 33], s[7 * 33]);
        *(u32x4*)(dst + (size_t)n * K + k0 + 8 * c) = o; }
    LDS_FENCE();
}
constexpr int IT_GU = 16 * 88, IT_D = 44 * 32, IT_FFN = 2 * IT_GU + IT_D, IT_WIN = 16 * 104, IT_WO = 16 * 32, IT_LAYER = 2 * IT_FFN + IT_WIN + IT_WO;
__device__ __forceinline__ void weight_item(const Args& A, const Ctx& C, int it, LAS float* scr) {
    const int l = it / IT_LAYER; int r = it % IT_LAYER;
    if (r < 2 * IT_FFN) {
        const int f = r / IT_FFN; const int q = r % IT_FFN;
        if (q < 2 * IT_GU) {
            const int which = q / IT_GU, idx = q % IT_GU, kb = idx / 88, nb = idx % 88, n0 = nb * 32;
            const float* W = (f == 0 ? (which == 0 ? PIN(7) : PIN(8)) : (which == 0 ? PIN(20) : PIN(21))) + (size_t)l * DM * FF;
            const int drow = (n0 >> 7) * 256 + (n0 & 127) + which * 128;
            bf16_t* dst = (bf16_t*)(PWS + WS_WGU + (size_t)(l * 2 + f) * SZ_WGU) + (size_t)drow * DM;
            transpose_item(W, DM, FF, kb * 64, n0, dst, scr, (C.tid & 63));
        } else {
            const int idx = q - 2 * IT_GU, kb = idx / 32, nb = idx % 32, n0 = nb * 32;
            const float* W = (f == 0 ? PIN(9) : PIN(22)) + (size_t)l * FF * DM;
            bf16_t* dst = (bf16_t*)(PWS + WS_WD + (size_t)(l * 2 + f) * SZ_WD) + (size_t)n0 * FF;
            transpose_item(W, FF, DM, kb * 64, n0, dst, scr, (C.tid & 63), 0.5f);
        }
        return;
    }
    r -= 2 * IT_FFN;
    if (r < IT_WIN) {
        const int kb = r / 104, nb = r % 104, n0 = nb * 32;
        const float* W = PIN(11) + (size_t)l * DM * NIN;
        int drow = n0;
        if (n0 < 256) drow = (n0 >> 7) * 256 + (n0 & 127);
        else if (n0 < 512) { const int j = n0 - 256; drow = (j >> 7) * 256 + 128 + (j & 127); }
        bf16_t* dst = (bf16_t*)(PWS + WS_WIN + (size_t)l * SZ_WIN) + (size_t)drow * DM;
        transpose_item(W, DM, NIN, kb * 64, n0, dst, scr, (C.tid & 63));
        return;
    }
    r -= IT_WIN;
    {
        const int kb = r / 32, nb = r % 32, n0 = nb * 32;
        const float* W = PIN(18) + (size_t)l * DM * DM;
        bf16_t* dst = (bf16_t*)(PWS + WS_WO + (size_t)l * SZ_WO) + (size_t)n0 * DM;
        transpose_item(W, DM, DM, kb * 64, n0, dst, scr, (C.tid & 63));
    }
}

template <int MODE>
__device__ __forceinline__ void norm_phase(const Args& A, const Ctx& C, const float* g, int nsplit = 0) {
    int tl_ = C.tid; asm volatile("" : "+v"(tl_)); const int lane_ = tl_ & 63;
    const int gw = C.bid * 8 + C.wave, NGW = C.G * 8;
    f32x4 gv[4];
#pragma unroll
    for (int j = 0; j < 4; ++j) gv[j] = ((const f32x4*)g)[lane_ + 64 * j];
    for (int m = gw; m < MR; m += NGW) {
        const float* src = (MODE == 1) ? (m < MP ? PIN(0) + (size_t)m * DM : PIN(1) + (size_t)(m - MP) * DM) : WSP(float, WS_X) + (size_t)m * DM;
        const f32x4* xr = (const f32x4*)src + lane_;
        f32x4 v[4]; float s = 0.f;
#pragma unroll
        for (int j = 0; j < 4; ++j) { v[j] = xr[64 * j]; s += (v[j].x * v[j].x + v[j].y * v[j].y) + (v[j].z * v[j].z + v[j].w * v[j].w); }
        if (MODE != 1 && m >= MP) {
            const float* Pr = WSP(float, WS_SL) + (size_t)(m - MP) * DM;
#pragma unroll
            for (int j = 0; j < 4; ++j) {
                f32x4 pv[11];
#pragma unroll
                for (int p = 0; p < 11; ++p) pv[p] = (p < nsplit) ? ((const f32x4*)(Pr + (size_t)p * 128 * DM))[lane_ + 64 * j] : (f32x4){0.f, 0.f, 0.f, 0.f};
#pragma unroll
                for (int p = 0; p < 11; ++p) v[j] = v[j] + pv[p];
            }
            f32x4* xo = (f32x4*)(WSP(float, WS_X) + (size_t)m * DM) + lane_; s = 0.f;
#pragma unroll
            for (int j = 0; j < 4; ++j) { xo[64 * j] = v[j]; s += (v[j].x * v[j].x + v[j].y * v[j].y) + (v[j].z * v[j].z + v[j].w * v[j].w); }
        }
        const float rstd = 1.0f / sqrtf(wave_sum(s) * (1.f / DM) + EPS);
        if (MODE == 1) {
            f32x4* xo = (f32x4*)(WSP(float, WS_X) + (size_t)m * DM) + lane_;
#pragma unroll
            for (int j = 0; j < 4; ++j) xo[64 * j] = v[j];
        }
        if (MODE == 2) {
            f32x4* yo = (f32x4*)(POUT + (size_t)m * DM) + lane_;
#pragma unroll
            for (int j = 0; j < 4; ++j) yo[64 * j] = v[j] * rstd * gv[j];
        } else {
            u32x2* o8 = (u32x2*)(WSP(bf16_t, WS_XN) + (size_t)m * DM) + lane_;
#pragma unroll
            for (int j = 0; j < 4; ++j) { const f32x4 y = v[j] * rstd * gv[j]; u32x2 w; w.x = pk2(y.x, y.y); w.y = pk2(y.z, y.w); o8[64 * j] = w; }
        }
    }
}

__device__ __forceinline__ void prologue_phase(const Args& A, const Ctx& C, LAS unsigned char* lds) {
    LAS float* scr = (LAS float*)(lds + C.wave * 16384);
    const int gw = C.bid * 8 + C.wave, NGW = C.G * 8;
    for (int it = gw; it < DEPTH * IT_LAYER; it += NGW) weight_item(A, C, it, scr);
    const int gt = C.bid * NTHR + C.tid, NGT = C.G * NTHR;
    for (int c = gt; c < 512; c += NGT) {
        float v[4], mx = -1e30f;
#pragma unroll
        for (int l = 0; l < 4; ++l) { v[l] = PIN(16)[l * 512 + c]; mx = fmaxf(mx, v[l]); }
        float s = 0.f;
#pragma unroll
        for (int l = 0; l < 4; ++l) { v[l] = __expf(v[l] - mx); s += v[l]; }
        const float inv = 1.f / s; float cum = 0.f;
        WSP(float, WS_LB)[c] = 0.f;
#pragma unroll
        for (int l = 1; l < 4; ++l) { cum += v[l] * inv; WSP(float, WS_LB)[l * 512 + c] = cum; }
    }
    for (int i = gt; i < (MPAD - MR) * DM; i += NGT) { WSP(float, WS_X)[(size_t)MR * DM + i] = 0.f; WSP(bf16_t, WS_XN)[(size_t)MR * DM + i] = 0; WSP(bf16_t, WS_Y)[(size_t)MR * DM + i] = 0; }
    norm_phase<1>(A, C, PIN(6));
}

struct AttnRegs { u32x4 q[2], k[4], v[4]; };
__device__ __forceinline__ void attn_load(const Args& A, int item, int tid, AttnRegs& R) {
    const int br = item >> 9, rem = item & 511, b = rem >> 8, h = (rem >> 6) & 3, n = rem & 63;
    const int sh = 2 * br, nbc = 64 >> sh, r = n / nbc, cb = n % nbc;
    const bf16_t* Zb = WSP(bf16_t, WS_ZB) + (size_t)(b * SEQ) * ZW;
#pragma unroll
    for (int a = 0; a < 2; ++a) { const int i = tid + a * NTHR; const int qi = i >> 3, ch = i & 7; const int t = ((cb * 128 + qi) << sh) + r;
        R.q[a] = *(const u32x4*)(Zb + (size_t)t * ZW + ZQ + h * 64 + ch * 8); }
#pragma unroll
    for (int a = 0; a < 4; ++a) { const int i = tid + a * NTHR; const int ki = i >> 3, ch = i & 7; const int u = (cb - 1) * 128 + ki;
        const int t = ((u < 0 ? 0 : u) << sh) + r; const bf16_t* p = Zb + (size_t)t * ZW + h * 64 + ch * 8;
        R.k[a] = *(const u32x4*)(p + ZK); R.v[a] = *(const u32x4*)(p + ZV);
        if (u < 0) { R.k[a] = (u32x4){0u, 0u, 0u, 0u}; R.v[a] = (u32x4){0u, 0u, 0u, 0u}; } }
}
__device__ __forceinline__ void attn_item(const Args& A, const Ctx& C, int item, int next_item, AttnRegs& R, LAS unsigned char* lds) {
    const int br = item >> 9, rem = item & 511, b = rem >> 8, h = (rem >> 6) & 3, n = rem & 63;
    const int sh = 2 * br, nbc = 64 >> sh, r = n / nbc, cb = n % nbc;
    LAS bf16_t* Qs = (LAS bf16_t*)lds;
    LAS bf16_t* Ks = Qs + 128 * 72;
    LAS bf16_t* VT = Ks + 256 * 72;
    LAS bf16_t* Ps = VT + 64 * 280;
    const bf16_t* Zb = WSP(bf16_t, WS_ZB) + (size_t)(b * SEQ) * ZW;
    int tid = C.tid, w = C.wave; asm volatile("" : "+v"(tid), "+s"(w)); const int lane = tid & 63, fr = lane & 15, fq = lane >> 4;
    __syncthreads();
    {
#pragma unroll
        for (int a = 0; a < 2; ++a) { const int i = tid + a * NTHR; const int qi = i >> 3, ch = i & 7; *(LAS u32x4*)(Qs + qi * 72 + ch * 8) = R.q[a]; }
#pragma unroll
        for (int a = 0; a < 4; ++a) { const int i = tid + a * NTHR; const int ki = i >> 3, ch = i & 7;
            *(LAS u32x4*)(Ks + ki * 72 + ch * 8) = R.k[a];
            LAS bf16_t* vt = VT + (ch * 8) * 280 + ki; const u32x4 w4 = R.v[a];
            vt[0 * 280] = (bf16_t)(w4.x & 0xffffu); vt[1 * 280] = (bf16_t)(w4.x >> 16); vt[2 * 280] = (bf16_t)(w4.y & 0xffffu); vt[3 * 280] = (bf16_t)(w4.y >> 16);
            vt[4 * 280] = (bf16_t)(w4.z & 0xffffu); vt[5 * 280] = (bf16_t)(w4.z >> 16); vt[6 * 280] = (bf16_t)(w4.w & 0xffffu); vt[7 * 280] = (bf16_t)(w4.w >> 16); }
    }
    for (int i = tid; i < 1024; i += NTHR) VT[(i >> 4) * 280 + 256 + (i & 15)] = 0;
    __syncthreads();
    if (next_item >= 0) attn_load(A, next_item, tid, R);
    f32x4 s[9];
    {
        bf16x8 aq[2];
#pragma unroll
        for (int k = 0; k < 2; ++k) aq[k] = ldfrag(Qs, 72, 16 * w, 32 * k, lane);
#pragma unroll
        for (int j = 0; j < 9; ++j) { s[j] = (f32x4){0.f, 0.f, 0.f, 0.f};
#pragma unroll
            for (int k = 0; k < 2; ++k) { const bf16x8 bk = ldfrag(Ks, 72, 16 * (w + j), 32 * k, lane); s[j] = MFMA16(aq[k], bk, s[j]); } }
    }
    const float slope = exp2f(-2.f * (float)(h + 1));
    float mx[4] = {-1e30f, -1e30f, -1e30f, -1e30f};
#pragma unroll
    for (int j = 0; j < 9; ++j)
#pragma unroll
        for (int i = 0; i < 4; ++i) {
            const int qi = 16 * w + 4 * fq + i, ki = 16 * (w + j) + fr, jd = qi - ki + 128;
            const bool valid = (jd >= 0) && (jd <= 128) && (cb > 0 || ki >= 128);
            const float val = s[j][i] - slope * (float)(jd << sh);
            s[j][i] = valid ? val : -1e30f; mx[i] = fmaxf(mx[i], s[j][i]);
        }
    float ls[4];
#pragma unroll
    for (int i = 0; i < 4; ++i) { mx[i] = max16(mx[i]); ls[i] = 0.f; }
    LAS bf16_t* Pw = Ps + w * 16 * 168;
#pragma unroll
    for (int j = 0; j < 9; ++j)
#pragma unroll
        for (int i = 0; i < 4; ++i) { const float p = __expf(s[j][i] - mx[i]); ls[i] += p; Pw[(4 * fq + i) * 168 + j * 16 + fr] = (bf16_t)f2bf(p); }
#pragma unroll
    for (int e = 0; e < 4; ++e) { const int idx = lane * 4 + e; Pw[(idx >> 4) * 168 + 144 + (idx & 15)] = 0; }
#pragma unroll
    for (int i = 0; i < 4; ++i) ls[i] = sum16(ls[i]);
    LDS_FENCE();
    f32x4 o[4];
#pragma unroll
    for (int d = 0; d < 4; ++d) o[d] = (f32x4){0.f, 0.f, 0.f, 0.f};
#pragma unroll
    for (int ks = 0; ks < 5; ++ks) { const bf16x8 ap = ldfrag(Pw, 168, 0, 32 * ks, lane);
#pragma unroll
        for (int d = 0; d < 4; ++d) { const bf16x8 bv = ldfrag(VT, 280, 16 * d, 16 * w + 32 * ks, lane); o[d] = MFMA16(ap, bv, o[d]); } }
    float* OPb = WSP(float, WS_OP) + (size_t)br * MP * 256; float* LSb = WSP(float, WS_LSE) + (size_t)br * MP * 4;
#pragma unroll
    for (int i = 0; i < 4; ++i) {
        const int qi = 16 * w + 4 * fq + i; const int t = ((cb * 128 + qi) << sh) + r; const size_t grow = (size_t)b * SEQ + t;
        const float inv = 1.f / ls[i];
#pragma unroll
        for (int d = 0; d < 4; ++d) OPb[grow * 256 + h * 64 + 16 * d + fr] = o[d][i] * inv;
        if (fr == 0) LSb[grow * 4 + h] = mx[i] + __logf(ls[i]);
    }
}

__device__ __forceinline__ void chunk_cumsum(const float* src, LAS float* Bc, LAS float* Tot, int tid) {
    const int d = tid & 127, part = tid >> 7;
    float run = 0.f;
#pragma unroll
    for (int s = 0; s < 16; ++s) { run += src[(size_t)(part * 16 + s) * 512 + d]; Bc[(part * 16 + s) * 128 + d] = run; }
    Tot[part * 128 + d] = run;
    __syncthreads();
    float off = 0.f;
#pragma unroll
    for (int p = 0; p < 3; ++p) if (p < part) off += Tot[p * 128 + d];
#pragma unroll
    for (int s = 0; s < 16; ++s) Bc[(part * 16 + s) * 128 + d] += off;
    __syncthreads();
}
constexpr int H_BC = 0, H_TOT = 32768, H_A = 34816;
__device__ __forceinline__ void chunk_cumsum_regs(const float (&lf)[16], LAS float* Bc, LAS float* Tot, int tid) {
    const int d = tid & 127, part = tid >> 7;
    float run = 0.f;
#pragma unroll
    for (int s = 0; s < 16; ++s) { run += lf[s]; Bc[(part * 16 + s) * 128 + d] = run; }
    Tot[part * 128 + d] = run;
    __syncthreads();
    float off = 0.f;
#pragma unroll
    for (int p = 0; p < 3; ++p) if (p < part) off += Tot[p * 128 + d];
#pragma unroll
    for (int s = 0; s < 16; ++s) Bc[(part * 16 + s) * 128 + d] += off;
    __syncthreads();
}
struct H1Regs { u32x4 k[2], v[2]; float lf[16]; };
__device__ __forceinline__ void h1_load(const Args& A, int item, int tid, H1Regs& R) {
    const int bh = item >> 7, c = item & 127, b = bh >> 2, h = bh & 3; const size_t row0 = (size_t)b * SEQ + c * 64;
#pragma unroll
    for (int a = 0; a < 2; ++a) { const int i = tid + a * NTHR; const int s = i >> 4, ch = i & 15, d0 = ch * 8;
        const bf16_t* p = WSP(bf16_t, WS_ZB) + (row0 + s) * ZW + h * 128 + d0; R.k[a] = *(const u32x4*)(p + ZHK); R.v[a] = *(const u32x4*)(p + ZHV); }
    { const float* src = WSP(float, WS_LF) + row0 * 512 + h * 128; const int d = tid & 127, part = tid >> 7;
#pragma unroll
      for (int s = 0; s < 16; ++s) R.lf[s] = src[(size_t)(part * 16 + s) * 512 + d]; }
}
__device__ __forceinline__ void h1_item(const Args& A, const Ctx& C, int item, int next_item, H1Regs& R, LAS unsigned char* lds) {
    const int bh = item >> 7, c = item & 127, b = bh >> 2, h = bh & 3; const size_t row0 = (size_t)b * SEQ + c * 64;
    LAS float* Bc = (LAS float*)(lds + H_BC); LAS float* Tot = (LAS float*)(lds + H_TOT);
    LAS bf16_t* KT = (LAS bf16_t*)(lds + H_A);
    LAS bf16_t* VT = KT + 128 * 72;
    int tid = C.tid, w = C.wave; asm volatile("" : "+v"(tid), "+s"(w)); const int lane = tid & 63, fr = lane & 15, fq = lane >> 4;
    __syncthreads();
    chunk_cumsum_regs(R.lf, Bc, Tot, tid);
#pragma unroll
    for (int a = 0; a < 2; ++a) { const int i = tid + a * NTHR; const int s = i >> 4, ch = i & 15, d0 = ch * 8;
        const u32x4 kk = R.k[a], vv = R.v[a];
        const unsigned kw[4] = {kk.x, kk.y, kk.z, kk.w}, vw[4] = {vv.x, vv.y, vv.z, vv.w};
#pragma unroll
        for (int e = 0; e < 8; ++e) { const int d = d0 + e; const float kf = (e & 1) ? bfhi(kw[e >> 1]) : bflo(kw[e >> 1]);
            const float kt = kf * __expf(Bc[63 * 128 + d] - Bc[s * 128 + d]);
            KT[d * 72 + s] = (bf16_t)f2bf(kt);
            VT[d * 72 + s] = (bf16_t)((e & 1) ? (vw[e >> 1] >> 16) : (vw[e >> 1] & 0xffffu)); } }
    __syncthreads();
    if (next_item >= 0) h1_load(A, next_item, tid, R);
    f32x4 acc[8];
#pragma unroll
    for (int j = 0; j < 8; ++j) acc[j] = (f32x4){0.f, 0.f, 0.f, 0.f};
#pragma unroll
    for (int k = 0; k < 2; ++k) { const bf16x8 av = ldfrag(VT, 72, 16 * w, 32 * k, lane);
#pragma unroll
        for (int j = 0; j < 8; ++j) { const bf16x8 bk = ldfrag(KT, 72, 16 * j, 32 * k, lane); acc[j] = MFMA16(av, bk, acc[j]); } }
    float* SLi = WSP(float, WS_SL) + (size_t)item * 16384;
#pragma unroll
    for (int j = 0; j < 8; ++j)
#pragma unroll
        for (int i = 0; i < 4; ++i) SLi[(16 * w + 4 * fq + i) * 128 + 16 * j + fr] = acc[j][i];
    if (tid < 128) WSP(float, WS_DC)[(size_t)item * 128 + tid] = __expf(Bc[63 * 128 + tid]);
}

__device__ __forceinline__ void conv_item(const Args& A, const Ctx& C, int l, int item, LAS unsigned char* lds) {
    const int b = item >> 7, tt = item & 127, t0 = tt * 64;
    LAS bf16_t* Us = (LAS bf16_t*)lds;
    LAS float* Ys = (LAS float*)(lds + 48128);
    int tid = C.tid, w = C.wave; asm volatile("" : "+v"(tid), "+s"(w)); const int lane = tid & 63;
    __syncthreads();
    for (int i = tid; i < 94 * 32; i += NTHR) { const int rr = i >> 5, ch = i & 31; const int t = t0 - 30 + rr;
        u32x4 v = (u32x4){0u, 0u, 0u, 0u};
        if (t >= 0) v = *(const u32x4*)(WSP(bf16_t, WS_ZB) + ((size_t)b * SEQ + t) * ZW + ch * 8);
        *(LAS u32x4*)(Us + rr * 256 + ch * 8) = v; }
    __syncthreads();
    {
        const int c = tid & 255, half = tid >> 8;
        const float* Wl = PIN(12) + (size_t)l * 31 * 256;
        float wv[31];
#pragma unroll
        for (int k = 0; k < 31; ++k) wv[k] = Wl[k * 256 + c];
        const float bias = PIN(13)[l * 256 + c];
        float acc[32];
#pragma unroll
        for (int k = 0; k < 32; ++k) acc[k] = bias;
#pragma unroll
        for (int i = 0; i < 62; ++i) {
            const float x = bf2f(Us[(half * 32 + i) * 256 + c]);
#pragma unroll
            for (int k = 0; k < 32; ++k) { if (i - k >= 0 && i - k <= 30) acc[k] += wv[i - k] * x; }
        }
#pragma unroll
        for (int k = 0; k < 32; ++k) Ys[(half * 32 + k) * 257 + c] = acc[k];
    }
    __syncthreads();
    {
        const float* gl = PIN(14) + l * 256; const float* bl = PIN(15) + l * 256;
        float gg[4], bb[4];
#pragma unroll
        for (int j = 0; j < 4; ++j) { gg[j] = gl[lane + 64 * j]; bb[j] = bl[lane + 64 * j]; }
        for (int k = 0; k < 8; ++k) {
            const int tl = w * 8 + k; float v[4]; float s = 0.f;
#pragma unroll
            for (int j = 0; j < 4; ++j) { v[j] = Ys[tl * 257 + lane + 64 * j]; s += v[j]; }
            const float mean = wave_sum(s) * (1.f / 256.f); float q = 0.f;
#pragma unroll
            for (int j = 0; j < 4; ++j) { v[j] -= mean; q += v[j] * v[j]; }
            const float rstd = 1.0f / sqrtf(wave_sum(q) * (1.f / 256.f) + EPS);
            bf16_t* yo = WSP(bf16_t, WS_Y) + ((size_t)b * SEQ + t0 + tl) * DM;
#pragma unroll
            for (int j = 0; j < 4; ++j) yo[lane + 64 * j] = (bf16_t)f2bf(siluf_(v[j] * rstd * gg[j] + bb[j]));
        }
    }
    if (tt == 127) {
        float* oc = POUT + O_CP + (size_t)(l * 2 + b) * 30 * 256;
        for (int i = tid; i < 30 * 256; i += NTHR) oc[i] = bf2f(Us[64 * 256 + i]);
    }
}
__device__ __forceinline__ void conv_sample_item(const Args& A, const Ctx& C, int l, int b, LAS unsigned char* lds) {
    LAS float* Fs = (LAS float*)lds;
    LAS float* Ys = (LAS float*)(lds + 34816);
    int tid = C.tid, w = C.wave; asm volatile("" : "+v"(tid), "+s"(w)); const int lane = tid & 63;
    __syncthreads();
    const float* st = PIN(2) + (size_t)(l * DB + b) * 30 * 256;
    for (int i = tid; i < 30 * 256; i += NTHR) Fs[i] = st[i];
    for (int i = tid; i < 4 * 256; i += NTHR) Fs[30 * 256 + i] = bf2f(WSP(bf16_t, WS_ZB)[((size_t)MP + 4 * b + (i >> 8)) * ZW + (i & 255)]);
    __syncthreads();
    {
        const int c = tid & 255, half = tid >> 8;
        const float* Wl = PIN(12) + (size_t)l * 31 * 256;
        const float bias = PIN(13)[l * 256 + c];
        float a0 = bias, a1 = bias;
#pragma unroll
        for (int k = 0; k < 31; ++k) { const float wk = Wl[k * 256 + c]; a0 += wk * Fs[(2 * half + k) * 256 + c]; a1 += wk * Fs[(2 * half + 1 + k) * 256 + c]; }
        Ys[(2 * half) * 257 + c] = a0; Ys[(2 * half + 1) * 257 + c] = a1;
    }
    __syncthreads();
    if (w < 4) {
        const float* gl = PIN(14) + l * 256; const float* bl = PIN(15) + l * 256;
        float v[4]; float s = 0.f;
#pragma unroll
        for (int j = 0; j < 4; ++j) { v[j] = Ys[w * 257 + lane + 64 * j]; s += v[j]; }
        const float mean = wave_sum(s) * (1.f / 256.f); float q = 0.f;
#pragma unroll
        for (int j = 0; j < 4; ++j) { v[j] -= mean; q += v[j] * v[j]; }
        const float rstd = 1.0f / sqrtf(wave_sum(q) * (1.f / 256.f) + EPS);
        bf16_t* yo = WSP(bf16_t, WS_Y) + ((size_t)MP + 4 * b + w) * DM;
#pragma unroll
        for (int j = 0; j < 4; ++j) yo[lane + 64 * j] = (bf16_t)f2bf(siluf_(v[j] * rstd * gl[lane + 64 * j] + bl[lane + 64 * j]));
    }
    float* oc = POUT + O_CS + (size_t)(l * DB + b) * 30 * 256;
    for (int i = tid; i < 30 * 256; i += NTHR) oc[i] = Fs[4 * 256 + i];
}
__device__ __forceinline__ void attn_sample_item(const Args& A, const Ctx& C, int l, int item, LAS unsigned char* lds) {
    int tid = C.tid, w = C.wave; asm volatile("" : "+v"(tid), "+s"(w)); const int lane = tid & 63;
    const int pair = (w >= 3) ? ((w >= 6) ? 2 : 1) : 0, br = w - 3 * pair; const bool active = w < 6;
    const int idx = item * 2 + (active ? pair : 0); const int b = idx >> 4, t = (idx >> 2) & 3, h = idx & 3;
    LAS float* qs = (LAS float*)(lds + w * 1024);
    LAS float* ps = qs + 64;
    LAS float* res = (LAS float*)(lds + 8192);
    __syncthreads();
    const size_t srow = (size_t)MP + 4 * b + t;
    if (active) {
        qs[lane] = bf2f(WSP(bf16_t, WS_ZB)[srow * ZW + ZQ + h * 64 + lane]);
        LDS_FENCE();
        const float slope = exp2f(-2.f * (float)(h + 1));
        const float* ck = PIN(3) + (size_t)(l * DB + b) * 2048 * 256 + h * 64;
        const float* cv = PIN(4) + (size_t)(l * DB + b) * 2048 * 256 + h * 64;
        const int sh = 2 * br;
        float sc[3];
#pragma unroll
        for (int jj = 0; jj < 3; ++jj) {
            const int j = lane + 64 * jj; float sv = -1e30f;
            if (j <= 128) {
                const int ix = 2048 + t - (j << sh); float dot = 0.f;
                if (ix < 2048) { const f32x4* kp = (const f32x4*)(ck + (size_t)ix * 256);
#pragma unroll
                    for (int c4 = 0; c4 < 16; ++c4) { const f32x4 kv = kp[c4]; const f32x4 qv = *(const LAS f32x4*)(qs + 4 * c4); dot += (kv.x * qv.x + kv.y * qv.y) + (kv.z * qv.z + kv.w * qv.w); } }
                else { const bf16_t* kp = WSP(bf16_t, WS_ZB) + ((size_t)MP + 4 * b + (ix - 2048)) * ZW + ZK + h * 64;
#pragma unroll 8
                    for (int d = 0; d < 64; ++d) dot += bf2f(kp[d]) * qs[d]; }
                sv = dot - slope * (float)(j << sh);
            }
            sc[jj] = sv;
            if (jj == 1) asm volatile("" ::: "memory");
        }
        const float m = wave_max(fmaxf(fmaxf(sc[0], sc[1]), sc[2]));
        float lsum = 0.f;
#pragma unroll
        for (int jj = 0; jj < 3; ++jj) { const float p = __expf(sc[jj] - m); lsum += p; ps[lane + 64 * jj] = p; }
        lsum = wave_sum(lsum);
        LDS_FENCE();
        f32x4 o = (f32x4){0.f, 0.f, 0.f, 0.f};
        const int kg = lane >> 4, c4 = lane & 15;
#pragma unroll 11
        for (int j0 = 0; j0 < 132; j0 += 4) {
            const int j = j0 + kg;
            if (j <= 128) {
                const int ix = 2048 + t - (j << sh); f32x4 v;
                if (ix < 2048) v = *(const f32x4*)(cv + (size_t)ix * 256 + c4 * 4);
                else { const u32x2 r2 = *(const u32x2*)(WSP(bf16_t, WS_ZB) + ((size_t)MP + 4 * b + (ix - 2048)) * ZW + ZV + h * 64 + c4 * 4); v = (f32x4){bflo(r2.x), bfhi(r2.x), bflo(r2.y), bfhi(r2.y)}; }
                o += v * ps[j];
            }
        }
#pragma unroll
        for (int e = 0; e < 4; ++e) { o[e] += __shfl_xor(o[e], 16); o[e] += __shfl_xor(o[e], 32); }
        LAS float* rp = res + (pair * 3 + br) * 68;
        if (lane < 16) *(LAS f32x4*)(rp + 4 + lane * 4) = o;
        if (lane == 0) { rp[0] = m; rp[1] = lsum; }
    }
    __syncthreads();
    if (active && br == 0 && lane < 16) {
        const LAS float* r0 = res + (pair * 3) * 68; const LAS float* r1 = r0 + 68; const LAS float* r2 = r0 + 136;
        const float M = fmaxf(r0[0], fmaxf(r1[0], r2[0])); const float w0 = __expf(r0[0] - M), w1 = __expf(r1[0] - M), w2 = __expf(r2[0] - M);
        const float inv = 1.f / (r0[1] * w0 + r1[1] * w1 + r2[1] * w2);
        const f32x4 O = (*(const LAS f32x4*)(r0 + 4 + lane * 4) * w0 + *(const LAS f32x4*)(r1 + 4 + lane * 4) * w1 + *(const LAS f32x4*)(r2 + 4 + lane * 4) * w2) * inv;
        u32x2 wv; wv.x = pk2(O.x, O.y); wv.y = pk2(O.z, O.w);
        *(u32x2*)(WSP(bf16_t, WS_Y) + srow * DM + 256 + h * 64 + lane * 4) = wv;
    }
}
__device__ __forceinline__ void hgrn_sample_item(const Args& A, const Ctx& C, int l, int item, LAS unsigned char* lds) {
    const int b = item >> 2, h = item & 3; int tid = C.tid, w = C.wave; asm volatile("" : "+v"(tid), "+s"(w)); const int lane = tid & 63;
    LAS float* fs = (LAS float*)lds;
    LAS float* ks = fs + 512;
    LAS float* qq = ks + 512;
    LAS float* red = qq + 512;
    __syncthreads();
    { const int t = tid >> 7, d = tid & 127; const size_t row = (size_t)MP + 4 * b + t;
      fs[tid] = __expf(WSP(float, WS_LF)[row * 512 + h * 128 + d]); ks[tid] = bf2f(WSP(bf16_t, WS_ZB)[row * ZW + ZHK + h * 128 + d]); qq[tid] = bf2f(WSP(bf16_t, WS_ZB)[row * ZW + ZHQ + h * 128 + d]); }
    __syncthreads();
    const int v = tid & 127, dq = tid >> 7;
    const float* S0 = PIN(5) + (size_t)((l * DB + b) * 4 + h) * 16384;
    float S[32];
#pragma unroll
    for (int j = 0; j < 32; ++j) S[j] = S0[(dq * 32 + j) * 128 + v];
#pragma unroll
    for (int t = 0; t < 4; ++t) {
        const float vt = bf2f(WSP(bf16_t, WS_ZB)[((size_t)MP + 4 * b + t) * ZW + ZHV + h * 128 + v]);
        float op = 0.f;
#pragma unroll
        for (int j = 0; j < 32; ++j) { const int d = dq * 32 + j; S[j] = fs[t * 128 + d] * S[j] + ks[t * 128 + d] * vt; op += S[j] * qq[t * 128 + d]; }
        red[(t * 4 + dq) * 128 + v] = op;
    }
    float* So = POUT + O_HS + (size_t)((l * DB + b) * 4 + h) * 16384;
#pragma unroll
    for (int j = 0; j < 32; ++j) So[(dq * 32 + j) * 128 + v] = S[j];
    __syncthreads();
    if (w < 4) {
        const int t = w; const size_t row = (size_t)MP + 4 * b + t; const float* gn = PIN(17) + l * 128;
        float o[2]; float ss = 0.f;
#pragma unroll
        for (int j = 0; j < 2; ++j) { const int vv = lane + 64 * j; o[j] = red[(t * 4 + 0) * 128 + vv] + red[(t * 4 + 1) * 128 + vv] + red[(t * 4 + 2) * 128 + vv] + red[(t * 4 + 3) * 128 + vv]; ss += o[j] * o[j]; }
        const float rstd = 1.0f / sqrtf(wave_sum(ss) * (1.f / 128.f) + EPS);
#pragma unroll
        for (int j = 0; j < 2; ++j) { const int vv = lane + 64 * j; const float g = bf2f(WSP(bf16_t, WS_ZB)[row * ZW + ZHG + h * 128 + vv]);
            WSP(bf16_t, WS_Y)[row * DM + 512 + h * 128 + vv] = (bf16_t)f2bf(o[j] * rstd * gn[vv] * g); }
    }
}

#ifdef PROFILE_SIDE
#define MSTAMP(k) do { __syncthreads(); if (C.bid == 0 && C.tid == 0) { LAS unsigned* prof = (LAS unsigned*)(lds + 151040); const unsigned tn = (unsigned)__builtin_amdgcn_s_memrealtime(); prof[k] += tn - prof[15]; prof[15] = tn; } } while (0)
#else
#define MSTAMP(k) do {} while (0)
#endif
constexpr int NA_ATT = 1536, NA_H1 = 1024, NA_CONV = 256, NA_SATT = 256, NA_SCONV = 32, NA_SHG = 128;
constexpr int NA_TOTAL = NA_ATT + NA_H1 + NA_CONV + NA_SATT + NA_SCONV + NA_SHG;
__device__ __forceinline__ void mixerA_phase(const Args& A, const Ctx& C, int l, LAS unsigned char* lds) {
    int t0_ = C.tid; asm volatile("" : "+v"(t0_));
    { AttnRegs R = {}; int it = C.bid; if (it < NA_ATT) attn_load(A, it, t0_, R);
      for (; it < NA_ATT; it += C.G) attn_item(A, C, it, (it + C.G < NA_ATT) ? it + C.G : -1, R, lds); }
    { H1Regs R = {}; int it = C.bid; if (it < NA_H1) h1_load(A, it, t0_, R);
      for (; it < NA_H1; it += C.G) h1_item(A, C, it, (it + C.G < NA_H1) ? it + C.G : -1, R, lds); }
    for (int it = C.bid; it < NA_CONV; it += C.G) conv_item(A, C, l, it, lds);
    for (int it = C.bid; it < NA_SATT; it += C.G) attn_sample_item(A, C, l, it, lds);
    for (int it = C.bid; it < NA_SCONV; it += C.G) conv_sample_item(A, C, l, it, lds);
    for (int it = C.bid - NA_SCONV; it < NA_SHG; it += C.G) { if (it >= 0) hgrn_sample_item(A, C, l, it, lds); }
    __syncthreads();
}

__device__ __forceinline__ void mixerB_phase(const Args& A, const Ctx& C, int l) {
    int tid_ = C.tid; asm volatile("" : "+v"(tid_));
    const int gt = C.bid * NTHR + tid_, NGT = C.G * NTHR;
    for (int e = gt; e < 8 * 16384; e += NGT) {
        const int bh = e >> 14, vd = e & 16383, d = vd & 127, v = vd >> 7;
        float S = 0.f;
        const float* sl = WSP(float, WS_SL) + (size_t)bh * 128 * 16384 + vd; const float* dc = WSP(float, WS_DC) + (size_t)bh * 128 * 128 + d; bf16_t* sp = WSP(bf16_t, WS_SP) + (size_t)bh * 128 * 16384 + vd;
        float slA[16], dcA[16], slB[16], dcB[16];
#pragma unroll
        for (int k = 0; k < 16; ++k) { slA[k] = sl[(size_t)k * 16384]; dcA[k] = dc[k * 128]; }
#pragma unroll 1
        for (int c0 = 0; c0 < 128; c0 += 32) {
#pragma unroll
            for (int k = 0; k < 16; ++k) { slB[k] = sl[(size_t)(c0 + 16 + k) * 16384]; dcB[k] = dc[(c0 + 16 + k) * 128]; }
#pragma unroll
            for (int k = 0; k < 16; ++k) { sp[(size_t)(c0 + k) * 16384] = (bf16_t)f2bf(S); S = dcA[k] * S + slA[k]; }
            if (c0 + 32 < 128) {
#pragma unroll
                for (int k = 0; k < 16; ++k) { slA[k] = sl[(size_t)(c0 + 32 + k) * 16384]; dcA[k] = dc[(c0 + 32 + k) * 128]; }
            }
#pragma unroll
            for (int k = 0; k < 16; ++k) { sp[(size_t)(c0 + 16 + k) * 16384] = (bf16_t)f2bf(S); S = dcB[k] * S + slB[k]; }
        }
        POUT[O_HP + (size_t)(l * 8 + bh) * 16384 + d * 128 + v] = S;
    }
    for (int i = gt; i < MP * 64; i += NGT) {
        const int row = i >> 6, c4 = i & 63, h = c4 >> 4;
        const float l0 = WSP(float, WS_LSE)[(size_t)row * 4 + h], l1 = WSP(float, WS_LSE)[(size_t)(MP + row) * 4 + h], l2 = WSP(float, WS_LSE)[(size_t)(2 * MP + row) * 4 + h];
        const float m = fmaxf(l0, fmaxf(l1, l2)); float w0 = __expf(l0 - m), w1 = __expf(l1 - m), w2 = __expf(l2 - m);
        const float inv = 1.f / (w0 + w1 + w2); w0 *= inv; w1 *= inv; w2 *= inv;
        const f32x4 a = *(const f32x4*)(WSP(float, WS_OP) + (size_t)row * 256 + c4 * 4), bq = *(const f32x4*)(WSP(float, WS_OP) + ((size_t)MP + row) * 256 + c4 * 4), cq = *(const f32x4*)(WSP(float, WS_OP) + ((size_t)2 * MP + row) * 256 + c4 * 4);
        const f32x4 y = a * w0 + bq * w1 + cq * w2;
        u32x2 wv; wv.x = pk2(y.x, y.y); wv.y = pk2(y.z, y.w);
        *(u32x2*)(WSP(bf16_t, WS_Y) + (size_t)row * DM + 256 + c4 * 4) = wv;
    }
}

constexpr int H3_QH = 34816, H3_KH = 52224, H3_QT = 69632, H3_VT = 87040, H3_ST = 105472, H3_P = 140288, H3_RED = 149504;
struct H3Regs { u32x4 q[2], k[2], v[2], s[4]; float lf[16]; };
__device__ __forceinline__ void h3_load(const Args& A, int item, int tid, H3Regs& R) {
    const int bh = item >> 7, c = item & 127, b = bh >> 2, h = bh & 3; const size_t row0 = (size_t)b * SEQ + c * 64;
#pragma unroll
    for (int a = 0; a < 2; ++a) { const int i = tid + a * NTHR; const int s = i >> 4, ch = i & 15, d0 = ch * 8;
        const bf16_t* p = WSP(bf16_t, WS_ZB) + (row0 + s) * ZW + h * 128 + d0; R.q[a] = *(const u32x4*)(p + ZHQ); R.k[a] = *(const u32x4*)(p + ZHK); R.v[a] = *(const u32x4*)(p + ZHV); }
    { const bf16_t* sp = WSP(bf16_t, WS_SP) + (size_t)item * 16384;
#pragma unroll
      for (int a = 0; a < 4; ++a) { const int i = tid + a * NTHR; const int v = i >> 4, ch = i & 15; R.s[a] = *(const u32x4*)(sp + v * 128 + ch * 8); } }
    { const float* src = WSP(float, WS_LF) + row0 * 512 + h * 128; const int d = tid & 127, part = tid >> 7;
#pragma unroll
      for (int s = 0; s < 16; ++s) R.lf[s] = src[(size_t)(part * 16 + s) * 512 + d]; }
}
__device__ __forceinline__ void h3_item(const Args& A, const Ctx& C, int l, int item, int next_item, H3Regs& R, LAS unsigned char* lds) {
    const int bh = item >> 7, c = item & 127, b = bh >> 2, h = bh & 3; const size_t row0 = (size_t)b * SEQ + c * 64;
    LAS float* Bc = (LAS float*)(lds + H_BC); LAS float* Tot = (LAS float*)(lds + H_TOT);
    LAS bf16_t* Qh = (LAS bf16_t*)(lds + H3_QH); LAS bf16_t* Kh = (LAS bf16_t*)(lds + H3_KH); LAS bf16_t* Qt = (LAS bf16_t*)(lds + H3_QT);
    LAS bf16_t* VT = (LAS bf16_t*)(lds + H3_VT);
    LAS bf16_t* ST = (LAS bf16_t*)(lds + H3_ST);
    LAS bf16_t* P = (LAS bf16_t*)(lds + H3_P);
    LAS float* red = (LAS float*)(lds + H3_RED);
    int tid = C.tid, w = C.wave; asm volatile("" : "+v"(tid), "+s"(w)); const int lane = tid & 63, fr = lane & 15, fq = lane >> 4;
    __syncthreads();
    chunk_cumsum_regs(R.lf, Bc, Tot, tid);
#pragma unroll
    for (int a = 0; a < 2; ++a) { const int i = tid + a * NTHR; const int s = i >> 4, ch = i & 15, d0 = ch * 8;
        const u32x4 qv = R.q[a], kk = R.k[a], vv = R.v[a];
        const unsigned qw[4] = {qv.x, qv.y, qv.z, qv.w}, kw[4] = {kk.x, kk.y, kk.z, kk.w}, vw[4] = {vv.x, vv.y, vv.z, vv.w};
        float qh[8], kh[8], qt[8];
#pragma unroll
        for (int e = 0; e < 8; ++e) { const int d = d0 + e; const float qf = (e & 1) ? bfhi(qw[e >> 1]) : bflo(qw[e >> 1]); const float kf = (e & 1) ? bfhi(kw[e >> 1]) : bflo(kw[e >> 1]);
            const float bt = Bc[s * 128 + d], bm = Bc[31 * 128 + d];
            qh[e] = qf * __expf(bt - bm); kh[e] = kf * __expf(bm - bt); qt[e] = qf * __expf(bt);
            VT[d * 72 + s] = (bf16_t)((e & 1) ? (vw[e >> 1] >> 16) : (vw[e >> 1] & 0xffffu)); }
        u32x4 o;
        o.x = pk2(qh[0], qh[1]); o.y = pk2(qh[2], qh[3]); o.z = pk2(qh[4], qh[5]); o.w = pk2(qh[6], qh[7]); *(LAS u32x4*)(Qh + s * 136 + d0) = o;
        o.x = pk2(kh[0], kh[1]); o.y = pk2(kh[2], kh[3]); o.z = pk2(kh[4], kh[5]); o.w = pk2(kh[6], kh[7]); *(LAS u32x4*)(Kh + s * 136 + d0) = o;
        o.x = pk2(qt[0], qt[1]); o.y = pk2(qt[2], qt[3]); o.z = pk2(qt[4], qt[5]); o.w = pk2(qt[6], qt[7]); *(LAS u32x4*)(Qt + s * 136 + d0) = o; }
#pragma unroll
    for (int a = 0; a < 4; ++a) { const int i = tid + a * NTHR; const int v = i >> 4, ch = i & 15; *(LAS u32x4*)(ST + v * 136 + ch * 8) = R.s[a]; }
    __syncthreads();
    const int ti = w >> 1;
    unsigned short gst[4][4];
#pragma unroll
    for (int i = 0; i < 4; ++i)
#pragma unroll
        for (int j = 0; j < 4; ++j) gst[i][j] = WSP(bf16_t, WS_ZB)[(row0 + 16 * ti + 4 * fq + i) * ZW + ZHG + h * 128 + 16 * (4 * (w & 1) + j) + fr];
    if (next_item >= 0) h3_load(A, next_item, tid, R);
    {
        const int si0 = 2 * (w & 1);
#pragma unroll
        for (int sj = 0; sj < 2; ++sj) { const int si = si0 + sj; f32x4 a = (f32x4){0.f, 0.f, 0.f, 0.f};
#pragma unroll
            for (int k = 0; k < 4; ++k) { const bf16x8 fa = ldfrag(Qh, 136, 16 * ti, 32 * k, lane), fb = ldfrag(Kh, 136, 16 * si, 32 * k, lane); a = MFMA16(fa, fb, a); }
#pragma unroll
            for (int i = 0; i < 4; ++i) { const int t = 16 * ti + 4 * fq + i, s = 16 * si + fr; const float pv = (s <= t) ? a[i] : 0.f; P[t * 72 + s] = (bf16_t)f2bf(pv); } }
    }
    __syncthreads();
    f32x4 acc[4];
    const int vt0 = 4 * (w & 1);
#pragma unroll
    for (int j = 0; j < 4; ++j) acc[j] = (f32x4){0.f, 0.f, 0.f, 0.f};
#pragma unroll
    for (int k = 0; k < 2; ++k) { const bf16x8 fa = ldfrag(P, 72, 16 * ti, 32 * k, lane);
#pragma unroll
        for (int j = 0; j < 4; ++j) { const bf16x8 fb = ldfrag(VT, 72, 16 * (vt0 + j), 32 * k, lane); acc[j] = MFMA16(fa, fb, acc[j]); } }
#pragma unroll
    for (int k = 0; k < 4; ++k) { const bf16x8 fa = ldfrag(Qt, 136, 16 * ti, 32 * k, lane);
#pragma unroll
        for (int j = 0; j < 4; ++j) { const bf16x8 fb = ldfrag(ST, 136, 16 * (vt0 + j), 32 * k, lane); acc[j] = MFMA16(fa, fb, acc[j]); } }
    float ss[4];
#pragma unroll
    for (int i = 0; i < 4; ++i) { float q = 0.f;
#pragma unroll
        for (int j = 0; j < 4; ++j) q += acc[j][i] * acc[j][i];
        ss[i] = sum16(q); }
    if (fr == 0) {
#pragma unroll
        for (int i = 0; i < 4; ++i) red[(w & 1) * 64 + 16 * ti + 4 * fq + i] = ss[i];
    }
    __syncthreads();
    const float* gn = PIN(17) + l * 128;
#pragma unroll
    for (int i = 0; i < 4; ++i) { const int t = 16 * ti + 4 * fq + i; const float rstd = 1.0f / sqrtf((red[t] + red[64 + t]) * (1.f / 128.f) + EPS);
        const size_t row = row0 + t;
#pragma unroll
        for (int j = 0; j < 4; ++j) { const int v = 16 * (vt0 + j) + fr; const float g = bf2f(gst[i][j]);
            WSP(bf16_t, WS_Y)[row * DM + 512 + h * 128 + v] = (bf16_t)f2bf(acc[j][i] * rstd * gn[v] * g); } }
}

#define XB_TMO      128
#define XB_XCNT(j)  (256  + 64 * (j))
#define XB_XSUB(j)  (1280 + 64 * (j))
#define XB_XGEN(j)  (2304 + 64 * (j))
#define XB_TOP      3328
#define XB_TOPGEN   3392
#define XCD_BAR_WORDS 3456
#define XB_SPIN_CAP (1u << 18)

__device__ __forceinline__ unsigned xb_ld(unsigned* p)              { return __hip_atomic_load(p, __ATOMIC_RELAXED, __HIP_MEMORY_SCOPE_AGENT); }
__device__ __forceinline__ unsigned xb_add(unsigned* p, unsigned v) { return __hip_atomic_fetch_add(p, v, __ATOMIC_RELAXED, __HIP_MEMORY_SCOPE_AGENT); }
__device__ __forceinline__ unsigned xb_xcc_id() { return (unsigned)__builtin_amdgcn_s_getreg((3 << 11) | 20) & 0xFu; }
#define XB_SPIN(cond, bar) do { unsigned _sp = 0; while (cond) { __builtin_amdgcn_s_sleep(1); \
    if ((++_sp & 255u) == 0u) { if (xb_ld(&(bar)[XB_TMO])) break; if (_sp > XB_SPIN_CAP) { atomicAdd(&(bar)[XB_TMO], 1u); break; } } } } while (0)

struct XcdBarrier {
    unsigned* bar; unsigned x;
    volatile LAS unsigned* st;
};

__device__ __forceinline__ XcdBarrier xcd_barrier_post(unsigned* bar, volatile LAS unsigned* st) {
    XcdBarrier b; b.bar = bar; b.x = xb_xcc_id(); b.st = st;
    if (threadIdx.x == 0) (void)xb_add(&bar[XB_XCNT(b.x)], 1u);
    return b;
}
__device__ __forceinline__ void xcd_barrier_complete(unsigned* bar, unsigned x, unsigned& nloc, unsigned& nx) {
    const unsigned G = gridDim.x * gridDim.y * gridDim.z;
    unsigned sum, cnt, mine, sp = 0u;
    for (;;) {
        sum = 0u; cnt = 0u; mine = 0u;
#pragma unroll
        for (unsigned j = 0; j < 16; ++j) { const unsigned c = xb_ld(&bar[XB_XCNT(j)]); sum += c; cnt += (c > 0u) ? 1u : 0u; mine = (j == x) ? c : mine; }
        if (sum == G) break;
        __builtin_amdgcn_s_sleep(1);
        if ((++sp & 255u) == 0u) { if (xb_ld(&bar[XB_TMO])) break; if (sp > XB_SPIN_CAP) { atomicAdd(&bar[XB_TMO], 1u); break; } }
    }
    nloc = mine > 0u ? mine : 1u; nx = cnt > 0u ? cnt : 1u;
}

__device__ __forceinline__ void xcd_barrier(const XcdBarrier& b) {
    asm volatile("s_waitcnt vmcnt(0)" ::: "memory");
    __syncthreads();
    unsigned tx_ = threadIdx.x; asm volatile("" : "+v"(tx_));
    if (tx_ == 0) {
        unsigned* bar = b.bar; unsigned bx_ = b.x; asm volatile("" : "+s"(bar), "+s"(bx_));
        __builtin_amdgcn_s_waitcnt(0);
        unsigned nloc = b.st[0], nx = b.st[1];
        if (nloc == 0u) { xcd_barrier_complete(bar, bx_, nloc, nx); b.st[0] = nloc; b.st[1] = nx; }
        const unsigned old = xb_add(&bar[XB_XSUB(bx_)], 1u);
        const unsigned gen = old / nloc;
        if (old + 1u == (gen + 1u) * nloc) {
            __builtin_amdgcn_fence(__ATOMIC_RELEASE, "agent");
            asm volatile("s_waitcnt vmcnt(0)" ::: "memory");
            const unsigned og = xb_add(&bar[XB_TOP], 1u);
            const unsigned tg = og / nx;
            if (og + 1u == (tg + 1u) * nx) xb_add(&bar[XB_TOPGEN], 1u);
            else XB_SPIN(xb_ld(&bar[XB_TOPGEN]) == tg, bar);
            __builtin_amdgcn_fence(__ATOMIC_ACQUIRE, "agent");
            xb_add(&bar[XB_XGEN(bx_)], 1u);
            asm volatile("s_waitcnt vmcnt(0)" ::: "memory");
        } else {
            XB_SPIN(xb_ld(&bar[XB_XGEN(bx_)]) == gen, bar);
            __builtin_amdgcn_fence(__ATOMIC_ACQUIRE, "agent");
            asm volatile("s_waitcnt vmcnt(0)" ::: "memory");
        }
    }
    __syncthreads();
}

__global__ void __launch_bounds__(NTHR, 2) fwd_megakernel(Args args) {
    cg::grid_group grid = cg::this_grid();
    LAS unsigned char* lds = (LAS unsigned char*)lds_raw;
    const Args& A = args;
    if (threadIdx.x < 26) ((LAS unsigned long long*)((LAS unsigned char*)lds_raw + PT_OFF))[threadIdx.x] = ((const unsigned long long*)&args)[threadIdx.x];
    if (threadIdx.x >= 32 && threadIdx.x < 36) ((LAS unsigned*)((LAS unsigned char*)lds_raw + PT_OFF + 256))[threadIdx.x - 32] = 0u;
    __syncthreads();
    XcdBarrier xbar = xcd_barrier_post((unsigned*)(args.ws + WS_BAR), (volatile LAS unsigned*)((LAS unsigned char*)lds_raw + PT_OFF + 256));
    Ctx C;
    C.tid = threadIdx.x; C.wave = __builtin_amdgcn_readfirstlane(C.tid >> 6); C.G = gridDim.x; C.bid = blockIdx.x;

#ifndef NO_PRO
    prologue_phase(A, C, lds);
#endif
    if (args.ws == nullptr) grid.sync();
    xcd_barrier(xbar);
#ifdef PROFILE_SIDE
    LAS unsigned* prof = (LAS unsigned*)(lds + 151040);
    if (C.bid == 0 && C.tid == 0) { for (int k = 0; k < 16; ++k) prof[k] = 0; prof[15] = (unsigned)__builtin_amdgcn_s_memrealtime(); prof[14] = prof[15]; }
#define PSTAMP(k) do { if (C.bid == 0 && C.tid == 0) { const unsigned tn = (unsigned)__builtin_amdgcn_s_memrealtime(); prof[k] += tn - prof[15]; prof[15] = tn; } } while (0)
#else
#define PSTAMP(k) do {} while (0)
#endif
#pragma unroll 1
    for (int l = 0; l < DEPTH; ++l) {
#pragma unroll 1
        for (int f = 0; f < 2; ++f) {
            if (f == 1) {
                norm_phase<0>(A, C, PIN(10) + l * DM, 11);
                xcd_barrier(xbar); PSTAMP(1);
                {
                    pg8::Gemm g{WSP(bf16_t, WS_XN), (const bf16_t*)(PWS + WS_WIN + (size_t)l * SZ_WIN), MPAD, NIN, DM}; pg8::StaticOrder S; S.init(MPAD, NIN, C.G, C.bid, DM);
                    EpiWin E{WSP(bf16_t, WS_ZB), WSP(float, WS_LF), WSP(float, WS_LB) + l * 512, POUT + O_KP + (size_t)l * 2 * 2048 * 256, POUT + O_VP + (size_t)l * 2 * 2048 * 256,
                             POUT + O_KS + (size_t)l * MS * 256, POUT + O_VS + (size_t)l * MS * 256};

#ifndef NO_GWIN
 pg8::gemm_phase<EpiWin, pg8::StaticOrder, true, true>(lds, g, S, E);
#endif

                }
                xcd_barrier(xbar); PSTAMP(4);
#ifndef NO_MA
                mixerA_phase(A, C, l, lds);
#endif
                xcd_barrier(xbar); PSTAMP(5);
#ifndef NO_MB
                mixerB_phase(A, C, l);
#endif
                xcd_barrier(xbar); PSTAMP(6);
#ifndef NO_MC
                { H3Regs R = {}; int it = C.bid; int t0_ = C.tid; asm volatile("" : "+v"(t0_)); if (it < 1024) h3_load(A, it, t0_, R);
                  for (; it < 1024; it += C.G) h3_item(A, C, l, it, (it + C.G < 1024) ? it + C.G : -1, R, lds); }
#endif
                __syncthreads();
                xcd_barrier(xbar); PSTAMP(7);
                {
                    pg8::Gemm g{WSP(bf16_t, WS_Y), (const bf16_t*)(PWS + WS_WO + (size_t)l * SZ_WO), MPAD, DM, DM}; pg8::SplitOrder S; S.init(MP, DM, C.G, C.bid, DM, 4);
                    EpiResid E{WSP(float, WS_X), WSP(float, WS_SL)};

#ifndef NO_GRES
 pg8::gemm_phase<EpiResid, pg8::SplitOrder, false, true>(lds, g, S, E);
#endif

                }
                xcd_barrier(xbar); PSTAMP(8);
                norm_phase<0>(A, C, PIN(19) + l * DM, 4);
                xcd_barrier(xbar); PSTAMP(1);
            }
            {
                pg8::Gemm g{WSP(bf16_t, WS_XN), (const bf16_t*)(PWS + WS_WGU + (size_t)(l * 2 + f) * SZ_WGU), MPAD, 2 * FF, DM}; pg8::StaticOrder S; S.init(MPAD, 2 * FF, C.G, C.bid, DM);
                EpiSwiglu E{WSP(bf16_t, WS_ACT)};

#ifndef NO_GSW
 pg8::gemm_phase<EpiSwiglu, pg8::StaticOrder, true, true>(lds, g, S, E);
#endif

            }
            xcd_barrier(xbar); PSTAMP(2);
            {
                pg8::Gemm g{WSP(bf16_t, WS_ACT), (const bf16_t*)(PWS + WS_WD + (size_t)(l * 2 + f) * SZ_WD), MPAD, DM, FF}; pg8::SplitOrder S; S.init(MP, DM, C.G, C.bid, FF, 11);
                EpiResid E{WSP(float, WS_X), WSP(float, WS_SL)};

#ifndef NO_GRES
 pg8::gemm_phase<EpiResid, pg8::SplitOrder, false, true>(lds, g, S, E);
#endif

            }
            xcd_barrier(xbar); PSTAMP(3);
        }
        if (l + 1 < DEPTH) { norm_phase<0>(A, C, PIN(6) + (l + 1) * DM, 11); xcd_barrier(xbar); PSTAMP(1); }
    }
    norm_phase<2>(A, C, PIN(23), 11);
#ifdef PROFILE_SIDE
    xcd_barrier(xbar); PSTAMP(1);
    for (int q = 0; q < 16; ++q) xcd_barrier(xbar);
    PSTAMP(12);
    if (C.bid == 0 && C.tid == 0) {
        prof[9] = prof[15] - prof[14];
#pragma unroll 1
        for (int k = 1; k < 10; ++k) { const unsigned n = prof[k] / 100u;
            const size_t off = (k == 1) ? O_YS : (k == 2) ? O_CP : (k == 3) ? O_CS : (k == 4) ? O_KP : (k == 5) ? O_VP : (k == 6) ? O_KS : (k == 7) ? O_VS : (k == 8) ? O_HP : O_HS;
            for (unsigned i = 0; i < n && i < 60000u; ++i) ((unsigned*)POUT)[off + i] = 0xAAAAAAAAu; }
    }
#endif
}

extern "C" void kernel_launch(void* const* d_in, const int* in_sizes, int n_in, void* d_out, int out_size, void* d_ws, size_t ws_size, hipStream_t stream) {
    static int grid = 0;
    if (grid == 0) {
        if (n_in != 24 || (size_t)out_size != O_END || ws_size < WS_END) { fprintf(stderr, "kernel_launch: unexpected shapes: n_in %d out %d ws %zu (need %zu)\n", n_in, out_size, ws_size, (size_t)WS_END); grid = -1; return; }
        int dev = 0, cus = 0, per_cu = 0;
        hipGetDevice(&dev);
        hipDeviceGetAttribute(&cus, hipDeviceAttributeMultiprocessorCount, dev);
        if (hipFuncSetAttribute((const void*)fwd_megakernel, hipFuncAttributeMaxDynamicSharedMemorySize, LDS_BYTES) != hipSuccess) { fprintf(stderr, "kernel_launch: hipFuncSetAttribute failed\n"); grid = -1; return; }
        hipOccupancyMaxActiveBlocksPerMultiprocessor(&per_cu, (const void*)fwd_megakernel, NTHR, LDS_BYTES);
        if (per_cu < 1) { fprintf(stderr, "kernel_launch: occupancy query says %d blocks/CU\n", per_cu); per_cu = 1; }
        (void)hipGetLastError();
        grid = cus;
    }
    if (grid < 0) return;
    Args a{};
    for (int i = 0; i < 24; ++i) a.in[i] = (const float*)d_in[i];
    a.out = (float*)d_out; a.ws = (unsigned char*)d_ws;
    (void)hipMemsetAsync((unsigned char*)d_ws + WS_BAR, 0, WS_BAR_BYTES, stream);
    void* kargs[] = {&a};
    hipError_t e = hipLaunchCooperativeKernel((const void*)fwd_megakernel, dim3(grid), dim3(NTHR), kargs, LDS_BYTES, stream);
    if (e != hipSuccess) fprintf(stderr, "cooperative launch failed: %s (grid %d)\n", hipGetErrorString(e), grid);
}
```

```cpp
#include <hip/hip_runtime.h>
#include <hip/hip_cooperative_groups.h>
#include <cstdio>
#include <cstdint>
namespace cg = cooperative_groups;
namespace pg8 {
#define PG8_LAS __attribute__((address_space(3)))
typedef unsigned short bf16_t;
typedef short bf16x8 __attribute__((ext_vector_type(8)));
typedef float f32x4 __attribute__((ext_vector_type(4)));
typedef unsigned u32x4 __attribute__((ext_vector_type(4)));
constexpr int BM = 256, BK = 64, HALF = 128, HTB = HALF * BK * 2  , STAGE_BYTES = 8 * HTB, NXCD = 8, WGM = 8;

__host__ __device__ __forceinline__ int lds_byte(int r, int c) { const int st = (r >> 4) * 2 + (c >> 5), rr = r & 15, cc = c & 31, ob = rr * 64 + cc * 2; return st * 1024 + (ob ^ (((ob >> 9) & 1) << 5)); }
__host__ __device__ __forceinline__ void stage_rc(int b, int& R, int& C) { const int st = b / 1024, sb = b % 1024, swz = sb ^ (((sb >> 9) & 1) << 5); R = (st >> 1) * 16 + swz / 64; C = (st & 1) * 32 + (swz % 64) / 2; }
__host__ __device__ __forceinline__ int perm32(int rho) { const int n = rho >> 4, i = rho & 15; return 8 * (i >> 2) + 4 * n + (i & 3); }

struct Unit { int pm, pn, kt0, nt; };
struct Gemm { const bf16_t* A; const bf16_t* Bt; int M, N, K; };

struct StaticOrder {
    int nM, nN, nwg, G, c, ntk;
    __host__ __device__ __forceinline__ void init(int M, int N, int G_, int c_, int K_) { nM = M / BM; nN = N / BM; nwg = nM * nN; G = G_; c = c_; ntk = K_ / BK; }
    __host__ __device__ __forceinline__ void map(long L, int& pm, int& pn) const {
        int wgid = (int)L; { const int q = nwg / NXCD, r = nwg % NXCD, xcd = wgid % NXCD, off = wgid / NXCD; wgid = (xcd < r ? xcd * (q + 1) : r * (q + 1) + (xcd - r) * q) + off; }
        const int nig = WGM * nN, gid = wgid / nig, fm = gid * WGM, gsz = (nM - fm) < WGM ? (nM - fm) : WGM;
        pm = fm + ((wgid % nig) % gsz); pn = (wgid % nig) / gsz;
    }
    __host__ __device__ __forceinline__ bool next(int i, Unit& u) const {
        const long L = (long)i * G + c; const bool ok = L < nwg; int pm, pn; map(ok ? L : 0, pm, pn);
        u.pm = pm; u.pn = pn; u.kt0 = 0; u.nt = ntk; return ok;
    }
    __device__ __forceinline__ void a_ready(const Unit&) const {}
    __device__ __forceinline__ void done(const Unit&) const {}
};

struct SplitOrder {
    StaticOrder P; int nsplit;
    __host__ __device__ __forceinline__ void init(int Mp, int N, int G_, int c_, int K_, int nsplit_) { P.init(Mp, N, G_, c_, K_); nsplit = nsplit_; }
    __host__ __device__ __forceinline__ bool next(int i, Unit& u) const {
        const long L = (long)i * P.G + P.c; const bool samp = L >= P.nwg; const int j = samp ? (int)(L - P.nwg) : 0;
        int pm, pn; P.map(samp ? 0 : L, pm, pn);
        const int nts = P.ntk / nsplit;
        u.pm = samp ? P.nM : pm; u.pn = samp ? (j % P.nN) : pn; u.nt = samp ? nts : P.ntk; u.kt0 = samp ? (j / P.nN) * nts : 0;
        return L < (long)P.nwg + P.nN * nsplit;
    }
    __device__ __forceinline__ void a_ready(const Unit&) const {}
    __device__ __forceinline__ void done(const Unit&) const {}
};

__device__ __forceinline__ unsigned cvt_pk_bf16(float lo, float hi) { unsigned r; asm volatile("v_cvt_pk_bf16_f32 %0, %1, %2" : "=v"(r) : "v"(lo), "v"(hi)); return r; }
template <class Epi, class Sched, bool ALIGN_EPI = false, bool SP2 = false>
__device__ __forceinline__ void gemm_phase(PG8_LAS unsigned char* lds, const Gemm g, const Sched& S, const Epi& E) {
    int tid_ = threadIdx.x; asm volatile("" : "+v"(tid_));
    const int tid = tid_, wid = __builtin_amdgcn_readfirstlane(tid >> 6), lane = tid & 63, wr = wid >> 2, wc = wid & 3, fr = lane & 15, fq = lane >> 4;
    const int K = g.K;
    unsigned voffA[2], voffB[2];
#pragma unroll
    for (int i = 0; i < 2; ++i) { int R, C; stage_rc(tid * 16 + i * 8192, R, C); const int Rb = Epi::PERM ? ((R & ~31) + perm32(R & 31)) : R;
        voffA[i] = (unsigned)(R * K + C) * 2u; voffB[i] = (unsigned)(Rb * K + C) * 2u; }
    const size_t kstep = (size_t)(BK * 2);
    const size_t hstep = (size_t)HALF * K * 2;
    const size_t tstep = 2 * hstep;
    const unsigned ldsw = (unsigned)wid * 1024u;
    const int aoff = lds_byte(wr * 64 + fr, fq * 8), boff = lds_byte(wc * 32 + fr, fq * 8);
#define PG8_SA(b, h) (((b) * 2 + (h)) * HTB)
#define PG8_SB(b, h) ((4 + (b) * 2 + (h)) * HTB)
#define PG8_STAGE(bufoff, gbase, voff) do { _Pragma("unroll") for (int _i = 0; _i < 2; ++_i) \
        __builtin_amdgcn_global_load_lds((const unsigned*)((const char*)(gbase) + (voff)[_i]), (PG8_LAS unsigned*)(lds + (bufoff) + ldsw + _i * 8192), 16, 0, 0); } while (0)
#define PG8_LDA(dst, b, h) do { _Pragma("unroll") for (int m = 0; m < 4; ++m) _Pragma("unroll") for (int k = 0; k < 2; ++k) dst[m][k] = *(const PG8_LAS bf16x8*)(lds + PG8_SA(b, h) + aoff + m * 2048 + k * 1024); } while (0)
#define PG8_LDB(dst, b, h) do { _Pragma("unroll") for (int n = 0; n < 2; ++n) _Pragma("unroll") for (int k = 0; k < 2; ++k) dst[n][k] = *(const PG8_LAS bf16x8*)(lds + PG8_SB(b, h) + boff + n * 2048 + k * 1024); } while (0)
#define PG8_MMA(ai, bj, At, Bt) do { __builtin_amdgcn_s_setprio(1); _Pragma("unroll") for (int m = 0; m < 4; ++m) _Pragma("unroll") for (int n = 0; n < 2; ++n) _Pragma("unroll") for (int k = 0; k < 2; ++k) \
        acc[ai][bj][m][n] = __builtin_amdgcn_mfma_f32_16x16x32_bf16(Bt[n][k], At[m][k], acc[ai][bj][m][n], 0, 0, 0); __builtin_amdgcn_s_setprio(0); } while (0)
#define PG8_WAIT_V(n) asm volatile("s_waitcnt vmcnt(" #n ")" ::: "memory")
#define PG8_WAIT_L(n) asm volatile("s_waitcnt lgkmcnt(" #n ")" ::: "memory")
#define PG8_BAR __builtin_amdgcn_s_barrier()
#define PG8_SCHED __builtin_amdgcn_sched_barrier(0)
    Unit cur, nxt; int ui = 0;
    if (!S.next(0, cur)) return;
    f32x4 acc[2][2][4][2];
#pragma unroll
    for (int a = 0; a < 2; ++a)
#pragma unroll
        for (int b = 0; b < 2; ++b)
#pragma unroll
            for (int m = 0; m < 4; ++m)
#pragma unroll
                for (int n = 0; n < 2; ++n) acc[a][b][m][n] = (f32x4){0.f, 0.f, 0.f, 0.f};
    bf16x8 At[4][2], B0[2][2], B1[2][2];
    const char* cA = (const char*)g.A + (size_t)cur.pm * tstep + (size_t)cur.kt0 * kstep; const char* cB = (const char*)g.Bt + (size_t)cur.pn * tstep + (size_t)cur.kt0 * kstep;
    S.a_ready(cur);
    if constexpr (SP2) {
        PG8_STAGE(PG8_SB(0, 0), cB, voffB); PG8_STAGE(PG8_SB(0, 1), cB + hstep, voffB); PG8_STAGE(PG8_SA(0, 0), cA, voffA); PG8_STAGE(PG8_SA(0, 1), cA + hstep, voffA);
        if (wr == 1) PG8_BAR;
        PG8_WAIT_V(2); PG8_BAR;
        PG8_STAGE(PG8_SB(1, 0), cB + kstep, voffB); PG8_STAGE(PG8_SA(1, 0), cA + kstep, voffA); PG8_STAGE(PG8_SB(1, 1), cB + hstep + kstep, voffB);
        PG8_WAIT_V(6); PG8_BAR;
    } else {
        PG8_STAGE(PG8_SB(0, 0), cB, voffB); PG8_STAGE(PG8_SA(0, 0), cA, voffA); PG8_STAGE(PG8_SB(0, 1), cB + hstep, voffB); PG8_STAGE(PG8_SA(0, 1), cA + hstep, voffA);
        if (wr == 1) PG8_BAR;
        PG8_WAIT_V(4); PG8_BAR;
        PG8_STAGE(PG8_SB(1, 0), cB + kstep, voffB); PG8_STAGE(PG8_SA(1, 0), cA + kstep, voffA); PG8_STAGE(PG8_SB(1, 1), cB + hstep + kstep, voffB);
        PG8_WAIT_V(6); PG8_BAR;
    }
    for (;;) {
        const bool has_next = S.next(ui + 1, nxt);
        const char* nA = has_next ? (const char*)g.A + (size_t)nxt.pm * tstep + (size_t)nxt.kt0 * kstep : cA; const char* nB = has_next ? (const char*)g.Bt + (size_t)nxt.pn * tstep + (size_t)nxt.kt0 * kstep : cB;
        const int nt = cur.nt;
        for (int t = 0; t < nt; t += 2) {
            const bool last = (t == nt - 2);
            const char* a1 = cA + (size_t)(t + 1) * kstep;
            const char* a2 = last ? nA : cA + (size_t)(t + 2) * kstep; const char* b2 = last ? nB : cB + (size_t)(t + 2) * kstep;
            const char* a3 = a2 + kstep; const char* b3 = b2 + kstep;
            if (last && has_next) S.a_ready(nxt);
            if constexpr (SP2) {
            PG8_LDB(B0, 0, 0); PG8_LDB(B1, 0, 1); PG8_SCHED; PG8_LDA(At, 0, 0); PG8_STAGE(PG8_SA(1, 1), a1 + hstep, voffA);
            PG8_WAIT_V(8); PG8_WAIT_L(0); PG8_BAR; PG8_MMA(0, 0, At, B0); PG8_MMA(0, 1, At, B1); PG8_BAR; PG8_SCHED;
            PG8_LDA(At, 0, 1); PG8_STAGE(PG8_SB(0, 0), b2, voffB); PG8_STAGE(PG8_SB(0, 1), b2 + hstep, voffB); PG8_STAGE(PG8_SA(0, 0), a2, voffA);
            PG8_WAIT_V(8); PG8_WAIT_L(0); PG8_BAR; PG8_MMA(1, 0, At, B0); PG8_MMA(1, 1, At, B1); PG8_BAR; PG8_SCHED;
            PG8_LDB(B0, 1, 0); PG8_LDB(B1, 1, 1); PG8_SCHED; PG8_LDA(At, 1, 0); PG8_STAGE(PG8_SA(0, 1), a2 + hstep, voffA);
            PG8_WAIT_V(8); PG8_WAIT_L(0); PG8_BAR; PG8_MMA(0, 0, At, B0); PG8_MMA(0, 1, At, B1); PG8_BAR; PG8_SCHED;
            PG8_LDA(At, 1, 1); PG8_STAGE(PG8_SB(1, 0), b3, voffB); PG8_STAGE(PG8_SB(1, 1), b3 + hstep, voffB); PG8_STAGE(PG8_SA(1, 0), a3, voffA);
            PG8_WAIT_V(8); PG8_WAIT_L(0); PG8_BAR; PG8_MMA(1, 0, At, B0); PG8_MMA(1, 1, At, B1); PG8_BAR; PG8_SCHED;
            } else {
            PG8_LDB(B0, 0, 0); PG8_SCHED; PG8_LDA(At, 0, 0); PG8_STAGE(PG8_SA(1, 1), a1 + hstep, voffA);
            PG8_WAIT_L(8); PG8_BAR; PG8_WAIT_L(0); PG8_MMA(0, 0, At, B0); PG8_BAR; PG8_SCHED;
            PG8_LDB(B1, 0, 1); PG8_STAGE(PG8_SB(0, 0), b2, voffB);
            PG8_BAR; PG8_WAIT_L(0); PG8_MMA(0, 1, At, B1); PG8_BAR;
            PG8_LDA(At, 0, 1); PG8_STAGE(PG8_SA(0, 0), a2, voffA);
            PG8_BAR; PG8_WAIT_L(0); PG8_MMA(1, 0, At, B0); PG8_BAR; PG8_SCHED;
            PG8_STAGE(PG8_SB(0, 1), b2 + hstep, voffB);
            PG8_WAIT_V(6); PG8_BAR; PG8_MMA(1, 1, At, B1); PG8_BAR;
            PG8_LDB(B0, 1, 0); PG8_SCHED; PG8_LDA(At, 1, 0); PG8_STAGE(PG8_SA(0, 1), a2 + hstep, voffA);
            PG8_WAIT_L(8); PG8_BAR; PG8_WAIT_L(0); PG8_MMA(0, 0, At, B0); PG8_BAR; PG8_SCHED;
            PG8_LDB(B1, 1, 1); PG8_STAGE(PG8_SB(1, 0), b3, voffB);
            PG8_BAR; PG8_WAIT_L(0); PG8_MMA(0, 1, At, B1); PG8_BAR;
            PG8_LDA(At, 1, 1); PG8_STAGE(PG8_SA(1, 0), a3, voffA);
            PG8_BAR; PG8_WAIT_L(0); PG8_MMA(1, 0, At, B0); PG8_BAR; PG8_SCHED;
            PG8_STAGE(PG8_SB(1, 1), b3 + hstep, voffB);
            PG8_WAIT_V(6); PG8_BAR; PG8_MMA(1, 1, At, B1); PG8_BAR;
            }
        }
        if constexpr (ALIGN_EPI) { if (wr == 0) PG8_BAR; }
        if constexpr (!Epi::AFTER_DRAIN) { E(acc, cur, wr, wc, fr, fq); S.done(cur); }
        if (!has_next) break;
#pragma unroll
        for (int a = 0; a < 2; ++a)
#pragma unroll
            for (int b = 0; b < 2; ++b)
#pragma unroll
                for (int m = 0; m < 4; ++m)
#pragma unroll
                    for (int n = 0; n < 2; ++n) acc[a][b][m][n] = (f32x4){0.f, 0.f, 0.f, 0.f};
        cur = nxt; cA = nA; cB = nB; ++ui;
        if constexpr (ALIGN_EPI) { if (wr == 1) PG8_BAR; }
    }
    PG8_WAIT_V(0);
    if constexpr (!ALIGN_EPI) { if (wr == 0) PG8_BAR; }
    PG8_BAR;
    if constexpr (Epi::AFTER_DRAIN) { E.fused(acc, cur, wr, wc, fr, fq, lds, wid, lane); S.done(cur); }
#undef PG8_SA
#undef PG8_SB
#undef PG8_STAGE
#undef PG8_LDA
#undef PG8_LDB
#undef PG8_MMA
#undef PG8_WAIT_V
#undef PG8_WAIT_L
#undef PG8_BAR
#undef PG8_SCHED
}
}

#define LAS __attribute__((address_space(3)))
typedef unsigned short bf16_t;
typedef short bf16x8 __attribute__((ext_vector_type(8)));
typedef float f32x4 __attribute__((ext_vector_type(4)));
typedef unsigned u32x4 __attribute__((ext_vector_type(4)));
typedef unsigned u32x2 __attribute__((ext_vector_type(2)));

constexpr int DM = 1024, SEQ = 8192, NB = 2, DEPTH = 4, DB = 32, DS = 4;
constexpr int MP = NB * SEQ;
constexpr int MS = DB * DS;
constexpr int MR = MP + MS;
constexpr int MPAD = 16640;
constexpr int FF = 2816, NIN = 3328, ZW = 3072;
constexpr int ZQ = 256, ZK = 512, ZV = 768, ZHQ = 1024, ZHK = 1536, ZHV = 2048, ZHG = 2560;
constexpr float EPS = 1e-6f;
constexpr int NTHR = 512;
constexpr int LDS_BYTES = 151552;

constexpr size_t al256(size_t x) { return (x + 255) & ~(size_t)255; }
constexpr size_t SZ_WGU = (size_t)2 * FF * DM * 2, SZ_WD = (size_t)DM * FF * 2, SZ_WIN = (size_t)NIN * DM * 2, SZ_WO = (size_t)DM * DM * 2;
constexpr size_t WS_WGU = 0;
constexpr size_t WS_WD = WS_WGU + 8 * SZ_WGU;
constexpr size_t WS_WIN = WS_WD + 8 * SZ_WD;
constexpr size_t WS_WO = WS_WIN + 4 * SZ_WIN;
constexpr size_t WS_LB = WS_WO + 4 * SZ_WO;
constexpr size_t WS_X = al256(WS_LB + 4 * 512 * 4);
constexpr size_t WS_XN = WS_X + (size_t)MPAD * DM * 4;
constexpr size_t WS_ACT = WS_XN + (size_t)MPAD * DM * 2;
constexpr size_t WS_ZB = WS_ACT + (size_t)MPAD * FF * 2;
constexpr size_t WS_LF = WS_ZB + (size_t)MPAD * ZW * 2;
constexpr size_t WS_Y = WS_LF + (size_t)MPAD * 512 * 4;
constexpr size_t WS_OP = WS_Y + (size_t)MPAD * DM * 2;
constexpr size_t WS_LSE = WS_OP + (size_t)3 * MP * 256 * 4;
constexpr size_t WS_SL = WS_LSE + (size_t)3 * MP * 4 * 4;
constexpr size_t WS_SP = WS_SL + (size_t)1024 * 16384 * 4;
constexpr size_t WS_DC = WS_SP + (size_t)1024 * 16384 * 2;
constexpr size_t WS_BAR = WS_DC + (size_t)1024 * 128 * 4;
constexpr size_t WS_BAR_BYTES = 16384;
constexpr size_t WS_END = WS_BAR + WS_BAR_BYTES;

constexpr size_t O_YP = 0, O_YS = 16777216, O_CP = O_YS + 131072, O_CS = O_CP + 61440, O_KP = O_CS + 983040, O_VP = O_KP + 4194304,
                 O_KS = O_VP + 4194304, O_VS = O_KS + 131072, O_HP = O_VS + 131072, O_HS = O_HP + 524288, O_END = O_HS + 8388608;

struct Args {
    const float* in[24];
    float* out;
    unsigned char* ws;
};

struct Ctx { int tid, wave, G, bid; };
extern __shared__ __attribute__((aligned(16))) unsigned char lds_raw[];
constexpr int PT_OFF = 150528;
__device__ __forceinline__ unsigned long long ptab_ld(int k) {
    const unsigned long long v = ((const LAS unsigned long long*)((LAS unsigned char*)lds_raw + PT_OFF))[k];
    const unsigned lo = __builtin_amdgcn_readfirstlane((unsigned)v), hi = __builtin_amdgcn_readfirstlane((unsigned)(v >> 32));
    return ((unsigned long long)hi << 32) | lo;
}
#define GAS1 __attribute__((address_space(1)))
#define PIN(k) ((const float*)(const GAS1 float*)ptab_ld(k))
#define POUT ((float*)(GAS1 float*)ptab_ld(24))
#define PWS ((unsigned char*)(GAS1 unsigned char*)ptab_ld(25))
#define WSP(T, off) ((T*)(PWS + (off)))

__device__ __forceinline__ unsigned f2bf(float f) { unsigned u = __builtin_bit_cast(unsigned, f); return (u + 0x7fffu + ((u >> 16) & 1u)) >> 16; }
__device__ __forceinline__ unsigned pk2(float lo, float hi) { return f2bf(lo) | (f2bf(hi) << 16); }
__device__ __forceinline__ float bf2f(unsigned h) { return __builtin_bit_cast(float, (h & 0xffffu) << 16); }
__device__ __forceinline__ float bflo(unsigned w) { return __builtin_bit_cast(float, w << 16); }
__device__ __forceinline__ float bfhi(unsigned w) { return __builtin_bit_cast(float, w & 0xffff0000u); }
__device__ __forceinline__ float sigmoidf_(float x) { return __builtin_amdgcn_rcpf(1.f + __expf(-x)); }
__device__ __forceinline__ float siluf_(float x) { return x * sigmoidf_(x); }
__device__ __forceinline__ float wave_sum(float v) {
#pragma unroll
    for (int o = 1; o < 64; o <<= 1) v += __shfl_xor(v, o);
    return v;
}
__device__ __forceinline__ float wave_max(float v) {
#pragma unroll
    for (int o = 1; o < 64; o <<= 1) v = fmaxf(v, __shfl_xor(v, o));
    return v;
}
__device__ __forceinline__ float sum16(float v) { v += __shfl_xor(v, 1); v += __shfl_xor(v, 2); v += __shfl_xor(v, 4); v += __shfl_xor(v, 8); return v; }
__device__ __forceinline__ float max16(float v) { v = fmaxf(v, __shfl_xor(v, 1)); v = fmaxf(v, __shfl_xor(v, 2)); v = fmaxf(v, __shfl_xor(v, 4)); v = fmaxf(v, __shfl_xor(v, 8)); return v; }
__device__ __forceinline__ bf16x8 ldfrag(const LAS bf16_t* base, int ld, int r0, int k0, int lane) {
    return *(const LAS bf16x8*)(base + (r0 + (lane & 15)) * ld + k0 + 8 * (lane >> 4));
}
#define MFMA16(a, b, c) __builtin_amdgcn_mfma_f32_16x16x32_bf16((a), (b), (c), 0, 0, 0)
#define LDS_FENCE() asm volatile("s_waitcnt lgkmcnt(0)" ::: "memory")

struct EpiSwiglu {
    static constexpr bool PERM = true, AFTER_DRAIN = false;
    bf16_t* O;
    __device__ __forceinline__ void operator()(const f32x4 (&acc)[2][2][4][2], const pg8::Unit& u_, int wr, int wc_, int fr_, int fq_) const {
        pg8::Unit u = u_; int wc = wc_, fr = fr_, fq = fq_; asm volatile("" : "+s"(u.pm), "+s"(u.pn), "+v"(fr), "+v"(fq), "+s"(wc));
        const int row0 = u.pm * 256 + wr * 64 + fr, col0 = u.pn * 128 + wc * 32 + 8 * fq;
#pragma unroll
        for (int ai = 0; ai < 2; ++ai)
#pragma unroll
            for (int m = 0; m < 4; ++m) {
                bf16_t* rowp = O + (size_t)(row0 + ai * 128 + m * 16) * FF + col0;
                float v[8];
#pragma unroll
                for (int n = 0; n < 2; ++n)
#pragma unroll
                    for (int i = 0; i < 4; ++i) v[n * 4 + i] = siluf_(acc[ai][0][m][n][i]) * acc[ai][1][m][n][i];
                u32x4 w; w.x = pk2(v[0], v[1]); w.y = pk2(v[2], v[3]); w.z = pk2(v[4], v[5]); w.w = pk2(v[6], v[7]);
                *(u32x4*)rowp = w;
            }
    }
};
struct EpiResid {
    static constexpr bool PERM = false, AFTER_DRAIN = false;
    float* X; float* P;
    __device__ __forceinline__ void operator()(const f32x4 (&acc)[2][2][4][2], const pg8::Unit& u_, int wr, int wc_, int fr_, int fq_) const {
        pg8::Unit u = u_; int wc = wc_, fr = fr_, fq = fq_; asm volatile("" : "+s"(u.pm), "+s"(u.pn), "+v"(fr), "+v"(fq), "+s"(wc));
        const int row0 = u.pm * 256 + wr * 64 + fr, col0 = u.pn * 256 + wc * 32 + 4 * fq;
        if (u.pm == MP / 256) {
            float* Pb = P + (size_t)(u.kt0 / u.nt) * 128 * DM;
#pragma unroll
            for (int m = 0; m < 4; ++m) {
                float* p = Pb + (size_t)(wr * 64 + m * 16 + fr) * DM + col0;
#pragma unroll
                for (int bj = 0; bj < 2; ++bj)
#pragma unroll
                    for (int n = 0; n < 2; ++n) *(f32x4*)(p + bj * 128 + n * 16) = acc[0][bj][m][n];
            }
            return;
        }
#pragma unroll
        for (int ai = 0; ai < 2; ++ai)
#pragma unroll
            for (int m = 0; m < 4; ++m) {
                float* p = X + (size_t)(row0 + ai * 128 + m * 16) * DM + col0;
                f32x4 t[2][2];
#pragma unroll
                for (int bj = 0; bj < 2; ++bj)
#pragma unroll
                    for (int n = 0; n < 2; ++n) t[bj][n] = *(const f32x4*)(p + bj * 128 + n * 16);
#pragma unroll
                for (int bj = 0; bj < 2; ++bj)
#pragma unroll
                    for (int n = 0; n < 2; ++n) *(f32x4*)(p + bj * 128 + n * 16) = t[bj][n] + acc[ai][bj][m][n];
                if (m == 3) asm volatile("" ::: "memory");
            }
    }
};
struct EpiWin {
    static constexpr bool PERM = true, AFTER_DRAIN = false;
    bf16_t* ZB; float* LF; const float* LB  ; float* outK; float* outV; float* outKs; float* outVs;
    __device__ __forceinline__ void operator()(const f32x4 (&acc)[2][2][4][2], const pg8::Unit& u_, int wr, int wc_, int fr_, int fq_) const {
        pg8::Unit u = u_; int wc = wc_, fr = fr_, fq = fq_; asm volatile("" : "+s"(u.pm), "+s"(u.pn), "+v"(fr), "+v"(fq), "+s"(wc));
        const int row0 = u.pm * 256 + wr * 64 + fr; const int pn = u.pn; const int cw = wc * 32 + 8 * fq;
        if (pn < 2) {
#pragma unroll
            for (int ai = 0; ai < 2; ++ai)
#pragma unroll
                for (int m = 0; m < 4; ++m) {
                    const int row = row0 + ai * 128 + m * 16; float v[8];
#pragma unroll
                    for (int n = 0; n < 2; ++n)
#pragma unroll
                        for (int i = 0; i < 4; ++i) v[n * 4 + i] = acc[ai][0][m][n][i] * sigmoidf_(acc[ai][1][m][n][i]);
                    u32x4 w; w.x = pk2(v[0], v[1]); w.y = pk2(v[2], v[3]); w.z = pk2(v[4], v[5]); w.w = pk2(v[6], v[7]);
                    *(u32x4*)(ZB + (size_t)row * ZW + pn * 128 + cw) = w;
                }
            return;
        }
        int zcol; int kind;
        if (pn == 2) { zcol = ZQ; kind = 0; } else if (pn == 3) { zcol = ZK; kind = 1; } else if (pn == 4) { zcol = ZV; kind = 2; }
        else if (pn < 7) { zcol = ZHQ + (pn - 5) * 256; kind = 3; } else if (pn < 9) { zcol = ZHK + (pn - 7) * 256; kind = 4; }
        else if (pn < 11) { zcol = ZHV + (pn - 9) * 256; kind = 5; } else { zcol = ZHG + (pn - 11) * 256; kind = 3; }
#pragma unroll
        for (int bj = 0; bj < 2; ++bj) {
            const int cin = bj * 128 + cw;
            float lb[8];
            if (kind == 4) {
#pragma unroll
                for (int i = 0; i < 8; ++i) lb[i] = LB[(pn - 7) * 256 + cin + i];
            }
#pragma unroll
            for (int ai = 0; ai < 2; ++ai)
#pragma unroll
                for (int m = 0; m < 4; ++m) {
                    const int row = row0 + ai * 128 + m * 16; float v[8];
#pragma unroll
                    for (int n = 0; n < 2; ++n)
#pragma unroll
                        for (int i = 0; i < 4; ++i) v[n * 4 + i] = acc[ai][bj][m][n][i];
                    if (kind == 1 || kind == 2) {
                        float* dst = nullptr;
                        if (row < MP) { const int b = row >> 13, t = row & (SEQ - 1); if (t >= SEQ - 2048) dst = (kind == 1 ? outK : outV) + ((size_t)(b * 2048 + (t - (SEQ - 2048))) * 256 + cin); }
                        else if (row < MR) dst = (kind == 1 ? outKs : outVs) + ((size_t)(row - MP) * 256 + cin);
                        if (dst) { *(f32x4*)dst = (f32x4){v[0], v[1], v[2], v[3]}; *(f32x4*)(dst + 4) = (f32x4){v[4], v[5], v[6], v[7]}; }
                    }
                    if (kind == 0) {
#pragma unroll
                        for (int i = 0; i < 8; ++i) v[i] *= 0.125f;
                    } else if (kind == 3) {
#pragma unroll
                        for (int i = 0; i < 8; ++i) v[i] = siluf_(v[i]);
                    } else if (kind == 4) {
                        float lf[8];
#pragma unroll
                        for (int i = 0; i < 8; ++i) { const float sg = sigmoidf_(v[i]); const float f = lb[i] + (1.f - lb[i]) * sg; lf[i] = __logf(f); v[i] = (1.f - lb[i]) * sigmoidf_(-v[i]); }
                        float* lp = LF + (size_t)row * 512 + (pn - 7) * 256 + cin;
                        *(f32x4*)lp = (f32x4){lf[0], lf[1], lf[2], lf[3]}; *(f32x4*)(lp + 4) = (f32x4){lf[4], lf[5], lf[6], lf[7]};
                    }
                    u32x4 w; w.x = pk2(v[0], v[1]); w.y = pk2(v[2], v[3]); w.z = pk2(v[4], v[5]); w.w = pk2(v[6], v[7]);
                    *(u32x4*)(ZB + (size_t)row * ZW + zcol + cin) = w;
                }
        }
    }
};

__device__ __forceinline__ void transpose_item(const float* W, int K, int N, int k0, int n0, bf16_t* dst, LAS float* scr, int lane, float wscale = 1.0f) {
#pragma unroll 8
    for (int i = 0; i < 32; ++i) { const int kk = 2 * i + (lane >> 5); scr[kk * 33 + (lane & 31)] = wscale * W[(size_t)(k0 + kk) * N + n0 + (lane & 31)]; }
    LDS_FENCE();
    const int c = lane & 7;
#pragma unroll
    for (int j = 0; j < 4; ++j) { const int n = (lane >> 3) + 8 * j; const LAS float* s = scr + (8 * c) * 33 + n;
        u32x4 o; o.x = pk2(s[0 * 33], s[1 * 33]); o.y = pk2(s[2 * 33], s[3 * 33]); o.z = pk2(s[4 * 33], s[5 * 33]); o.w = pk2(s[6 * 33], s[7 * 33]);
        *(u32x4*)(dst + (size_t)n * K + k0 + 8 * c) = o; }
    LDS_FENCE();
}
constexpr int IT_GU = 16 * 88, IT_D = 44 * 32, IT_FFN = 2 * IT_GU + IT_D, IT_WIN = 16 * 104, IT_WO = 16 * 32, IT_LAYER = 2 * IT_FFN + IT_WIN + IT_WO;
__device__ __forceinline__ void weight_item(const Args& A, const Ctx& C, int it, LAS float* scr) {
    const int l = it / IT_LAYER; int r = it % IT_LAYER;
    if (r < 2 * IT_FFN) {
        const int f = r / IT_FFN; const int q = r % IT_FFN;
        if (q < 2 * IT_GU) {
            const int which = q / IT_GU, idx = q % IT_GU, kb = idx / 88, nb = idx % 88, n0 = nb * 32;
            const float* W = (f == 0 ? (which == 0 ? PIN(7) : PIN(8)) : (which == 0 ? PIN(20) : PIN(21))) + (size_t)l * DM * FF;
            const int drow = (n0 >> 7) * 256 + (n0 & 127) + which * 128;
            bf16_t* dst = (bf16_t*)(PWS + WS_WGU + (size_t)(l * 2 + f) * SZ_WGU) + (size_t)drow * DM;
            transpose_item(W, DM, FF, kb * 64, n0, dst, scr, (C.tid & 63));
        } else {
            const int idx = q - 2 * IT_GU, kb = idx / 32, nb = idx % 32, n0 = nb * 32;
            const float* W = (f == 0 ? PIN(9) : PIN(22)) + (size_t)l * FF * DM;
            bf16_t* dst = (bf16_t*)(PWS + WS_WD + (size_t)(l * 2 + f) * SZ_WD) + (size_t)n0 * FF;
            transpose_item(W, FF, DM, kb * 64, n0, dst, scr, (C.tid & 63), 0.5f);
        }
        return;
    }
    r -= 2 * IT_FFN;
    if (r < IT_WIN) {
        const int kb = r / 104, nb = r % 104, n0 = nb * 32;
        const float* W = PIN(11) + (size_t)l * DM * NIN;
        int drow = n0;
        if (n0 < 256) drow = (n0 >> 7) * 256 + (n0 & 127);
        else if (n0 < 512) { const int j = n0 - 256; drow = (j >> 7) * 256 + 128 + (j & 127); }
        bf16_t* dst = (bf16_t*)(PWS + WS_WIN + (size_t)l * SZ_WIN) + (size_t)drow * DM;
        transpose_item(W, DM, NIN, kb * 64, n0, dst, scr, (C.tid & 63));
        return;
    }
    r -= IT_WIN;
    {
        const int kb = r / 32, nb = r % 32, n0 = nb * 32;
        const float* W = PIN(18) + (size_t)l * DM * DM;
        bf16_t* dst = (bf16_t*)(PWS + WS_WO + (size_t)l * SZ_WO) + (size_t)n0 * DM;
        transpose_item(W, DM, DM, kb * 64, n0, dst, scr, (C.tid & 63));
    }
}

template <int MODE>
__device__ __forceinline__ void norm_phase(const Args& A, const Ctx& C, const float* g, int nsplit = 0) {
    int tl_ = C.tid; asm volatile("" : "+v"(tl_)); const int lane_ = tl_ & 63;
    const int gw = C.bid * 8 + C.wave, NGW = C.G * 8;
    f32x4 gv[4];
#pragma unroll
    for (int j = 0; j < 4; ++j) gv[j] = ((const f32x4*)g)[lane_ + 64 * j];
    f32x4 vn[4] = {};
    if (gw < MR) { const int m = gw;
        const float* src = (MODE == 1) ? (m < MP ? PIN(0) + (size_t)m * DM : PIN(1) + (size_t)(m - MP) * DM) : WSP(float, WS_X) + (size_t)m * DM;
#pragma unroll
        for (int j = 0; j < 4; ++j) vn[j] = ((const f32x4*)src + lane_)[64 * j]; }
    for (int m = gw; m < MR; m += NGW) {
        f32x4 v[4]; float s = 0.f;
#pragma unroll
        for (int j = 0; j < 4; ++j) v[j] = vn[j];
        { const int mn = m + NGW;
          if (mn < MR) { const float* srcn = (MODE == 1) ? (mn < MP ? PIN(0) + (size_t)mn * DM : PIN(1) + (size_t)(mn - MP) * DM) : WSP(float, WS_X) + (size_t)mn * DM;
#pragma unroll
            for (int j = 0; j < 4; ++j) vn[j] = ((const f32x4*)srcn + lane_)[64 * j]; } }
#pragma unroll
        for (int j = 0; j < 4; ++j) s += (v[j].x * v[j].x + v[j].y * v[j].y) + (v[j].z * v[j].z + v[j].w * v[j].w);
        if (MODE != 1 && m >= MP) {
            const float* Pr = WSP(float, WS_SL) + (size_t)(m - MP) * DM;
#pragma unroll
            for (int j = 0; j < 4; ++j) {
                f32x4 pv[11];
#pragma unroll
                for (int p = 0; p < 11; ++p) pv[p] = (p < nsplit) ? ((const f32x4*)(Pr + (size_t)p * 128 * DM))[lane_ + 64 * j] : (f32x4){0.f, 0.f, 0.f, 0.f};
#pragma unroll
                for (int p = 0; p < 11; ++p) v[j] = v[j] + pv[p];
            }
            f32x4* xo = (f32x4*)(WSP(float, WS_X) + (size_t)m * DM) + lane_; s = 0.f;
#pragma unroll
            for (int j = 0; j < 4; ++j) { xo[64 * j] = v[j]; s += (v[j].x * v[j].x + v[j].y * v[j].y) + (v[j].z * v[j].z + v[j].w * v[j].w); }
        }
        const float rstd = 1.0f / sqrtf(wave_sum(s) * (1.f / DM) + EPS);
        if (MODE == 1) {
            f32x4* xo = (f32x4*)(WSP(float, WS_X) + (size_t)m * DM) + lane_;
#pragma unroll
            for (int j = 0; j < 4; ++j) xo[64 * j] = v[j];
        }
        if (MODE == 2) {
            f32x4* yo = (f32x4*)(POUT + (size_t)m * DM) + lane_;
#pragma unroll
            for (int j = 0; j < 4; ++j) yo[64 * j] = v[j] * rstd * gv[j];
        } else {
            u32x2* o8 = (u32x2*)(WSP(bf16_t, WS_XN) + (size_t)m * DM) + lane_;
#pragma unroll
            for (int j = 0; j < 4; ++j) { const f32x4 y = v[j] * rstd * gv[j]; u32x2 w; w.x = pk2(y.x, y.y); w.y = pk2(y.z, y.w); o8[64 * j] = w; }
        }
    }
}

__device__ __forceinline__ void prologue_phase(const Args& A, const Ctx& C, LAS unsigned char* lds) {
    LAS float* scr = (LAS float*)(lds + C.wave * 16384);
    const int gw = C.bid * 8 + C.wave, NGW = C.G * 8;
    for (int it = gw; it < DEPTH * IT_LAYER; it += NGW) weight_item(A, C, it, scr);
    const int gt = C.bid * NTHR + C.tid, NGT = C.G * NTHR;
    for (int c = gt; c < 512; c += NGT) {
        float v[4], mx = -1e30f;
#pragma unroll
        for (int l = 0; l < 4; ++l) { v[l] = PIN(16)[l * 512 + c]; mx = fmaxf(mx, v[l]); }
        float s = 0.f;
#pragma unroll
        for (int l = 0; l < 4; ++l) { v[l] = __expf(v[l] - mx); s += v[l]; }
        const float inv = 1.f / s; float cum = 0.f;
        WSP(float, WS_LB)[c] = 0.f;
#pragma unroll
        for (int l = 1; l < 4; ++l) { cum += v[l] * inv; WSP(float, WS_LB)[l * 512 + c] = cum; }
    }
    for (int i = gt; i < (MPAD - MR) * DM; i += NGT) { WSP(float, WS_X)[(size_t)MR * DM + i] = 0.f; WSP(bf16_t, WS_XN)[(size_t)MR * DM + i] = 0; WSP(bf16_t, WS_Y)[(size_t)MR * DM + i] = 0; }
    norm_phase<1>(A, C, PIN(6));
}

struct AttnRegs { u32x4 q[2], k[4], v[4]; };
__device__ __forceinline__ void attn_load(const Args& A, int item, int tid, AttnRegs& R) {
    const int br = item >> 9, rem = item & 511, b = rem >> 8, h = (rem >> 6) & 3, n = rem & 63;
    const int sh = 2 * br, nbc = 64 >> sh, r = n / nbc, cb = n % nbc;
    const bf16_t* Zb = WSP(bf16_t, WS_ZB) + (size_t)(b * SEQ) * ZW;
#pragma unroll
    for (int a = 0; a < 2; ++a) { const int i = tid + a * NTHR; const int qi = i >> 3, ch = i & 7; const int t = ((cb * 128 + qi) << sh) + r;
        R.q[a] = *(const u32x4*)(Zb + (size_t)t * ZW + ZQ + h * 64 + ch * 8); }
#pragma unroll
    for (int a = 0; a < 4; ++a) { const int i = tid + a * NTHR; const int ki = i >> 3, ch = i & 7; const int u = (cb - 1) * 128 + ki;
        const int t = ((u < 0 ? 0 : u) << sh) + r; const bf16_t* p = Zb + (size_t)t * ZW + h * 64 + ch * 8;
        R.k[a] = *(const u32x4*)(p + ZK); R.v[a] = *(const u32x4*)(p + ZV);
        if (u < 0) { R.k[a] = (u32x4){0u, 0u, 0u, 0u}; R.v[a] = (u32x4){0u, 0u, 0u, 0u}; } }
}
__device__ __forceinline__ void attn_item(const Args& A, const Ctx& C, int item, int next_item, AttnRegs& R, LAS unsigned char* lds) {
    const int br = item >> 9, rem = item & 511, b = rem >> 8, h = (rem >> 6) & 3, n = rem & 63;
    const int sh = 2 * br, nbc = 64 >> sh, r = n / nbc, cb = n % nbc;
    LAS bf16_t* Qs = (LAS bf16_t*)lds;
    LAS bf16_t* Ks = Qs + 128 * 72;
    LAS bf16_t* VT = Ks + 256 * 72;
    LAS bf16_t* Ps = VT + 64 * 280;
    const bf16_t* Zb = WSP(bf16_t, WS_ZB) + (size_t)(b * SEQ) * ZW;
    int tid = C.tid, w = C.wave; asm volatile("" : "+v"(tid), "+s"(w)); const int lane = tid & 63, fr = lane & 15, fq = lane >> 4;
    __syncthreads();
    {
#pragma unroll
        for (int a = 0; a < 2; ++a) { const int i = tid + a * NTHR; const int qi = i >> 3, ch = i & 7; *(LAS u32x4*)(Qs + qi * 72 + ch * 8) = R.q[a]; }
#pragma unroll
        for (int a = 0; a < 4; ++a) { const int i = tid + a * NTHR; const int ki = i >> 3, ch = i & 7;
            *(LAS u32x4*)(Ks + ki * 72 + ch * 8) = R.k[a];
            LAS bf16_t* vt = VT + (ch * 8) * 280 + ki; const u32x4 w4 = R.v[a];
            vt[0 * 280] = (bf16_t)(w4.x & 0xffffu); vt[1 * 280] = (bf16_t)(w4.x >> 16); vt[2 * 280] = (bf16_t)(w4.y & 0xffffu); vt[3 * 280] = (bf16_t)(w4.y >> 16);
            vt[4 * 280] = (bf16_t)(w4.z & 0xffffu); vt[5 * 280] = (bf16_t)(w4.z >> 16); vt[6 * 280] = (bf16_t)(w4.w & 0xffffu); vt[7 * 280] = (bf16_t)(w4.w >> 16); }
    }
    for (int i = tid; i < 1024; i += NTHR) VT[(i >> 4) * 280 + 256 + (i & 15)] = 0;
    __syncthreads();
    if (next_item >= 0) attn_load(A, next_item, tid, R);
    f32x4 s[9];
    {
        bf16x8 aq[2];
#pragma unroll
        for (int k = 0; k < 2; ++k) aq[k] = ldfrag(Qs, 72, 16 * w, 32 * k, lane);
#pragma unroll
        for (int j = 0; j < 9; ++j) { s[j] = (f32x4){0.f, 0.f, 0.f, 0.f};
#pragma unroll
            for (int k = 0; k < 2; ++k) { const bf16x8 bk = ldfrag(Ks, 72, 16 * (w + j), 32 * k, lane); s[j] = MFMA16(aq[k], bk, s[j]); } }
    }
    const float slope = exp2f(-2.f * (float)(h + 1));
    float mx[4] = {-1e30f, -1e30f, -1e30f, -1e30f};
#pragma unroll
    for (int j = 0; j < 9; ++j)
#pragma unroll
        for (int i = 0; i < 4; ++i) {
            const int qi = 16 * w + 4 * fq + i, ki = 16 * (w + j) + fr, jd = qi - ki + 128;
            const bool valid = (jd >= 0) && (jd <= 128) && (cb > 0 || ki >= 128);
            const float val = s[j][i] - slope * (float)(jd << sh);
            s[j][i] = valid ? val : -1e30f; mx[i] = fmaxf(mx[i], s[j][i]);
        }
    float ls[4];
#pragma unroll
    for (int i = 0; i < 4; ++i) { mx[i] = max16(mx[i]); ls[i] = 0.f; }
    LAS bf16_t* Pw = Ps + w * 16 * 168;
#pragma unroll
    for (int j = 0; j < 9; ++j)
#pragma unroll
        for (int i = 0; i < 4; ++i) { const float p = __expf(s[j][i] - mx[i]); ls[i] += p; Pw[(4 * fq + i) * 168 + j * 16 + fr] = (bf16_t)f2bf(p); }
#pragma unroll
    for (int e = 0; e < 4; ++e) { const int idx = lane * 4 + e; Pw[(idx >> 4) * 168 + 144 + (idx & 15)] = 0; }
#pragma unroll
    for (int i = 0; i < 4; ++i) ls[i] = sum16(ls[i]);
    LDS_FENCE();
    f32x4 o[4];
#pragma unroll
    for (int d = 0; d < 4; ++d) o[d] = (f32x4){0.f, 0.f, 0.f, 0.f};
#pragma unroll
    for (int ks = 0; ks < 5; ++ks) { const bf16x8 ap = ldfrag(Pw, 168, 0, 32 * ks, lane);
#pragma unroll
        for (int d = 0; d < 4; ++d) { const bf16x8 bv = ldfrag(VT, 280, 16 * d, 16 * w + 32 * ks, lane); o[d] = MFMA16(ap, bv, o[d]); } }
    float* OPb = WSP(float, WS_OP) + (size_t)br * MP * 256; float* LSb = WSP(float, WS_LSE) + (size_t)br * MP * 4;
#pragma unroll
    for (int i = 0; i < 4; ++i) {
        const int qi = 16 * w + 4 * fq + i; const int t = ((cb * 128 + qi) << sh) + r; const size_t grow = (size_t)b * SEQ + t;
        const float inv = 1.f / ls[i];
#pragma unroll
        for (int d = 0; d < 4; ++d) OPb[grow * 256 + h * 64 + 16 * d + fr] = o[d][i] * inv;
        if (fr == 0) LSb[grow * 4 + h] = mx[i] + __logf(ls[i]);
    }
}

__device__ __forceinline__ void chunk_cumsum(const float* src, LAS float* Bc, LAS float* Tot, int tid) {
    const int d = tid & 127, part = tid >> 7;
    float run = 0.f;
#pragma unroll
    for (int s = 0; s < 16; ++s) { run += src[(size_t)(part * 16 + s) * 512 + d]; Bc[(part * 16 + s) * 128 + d] = run; }
    Tot[part * 128 + d] = run;
    __syncthreads();
    float off = 0.f;
#pragma unroll
    for (int p = 0; p < 3; ++p) if (p < part) off += Tot[p * 128 + d];
#pragma unroll
    for (int s = 0; s < 16; ++s) Bc[(part * 16 + s) * 128 + d] += off;
    __syncthreads();
}
constexpr int H_BC = 0, H_TOT = 32768, H_A = 34816;
__device__ __forceinline__ void chunk_cumsum_regs(const float (&lf)[16], LAS float* Bc, LAS float* Tot, int tid) {
    const int d = tid & 127, part = tid >> 7;
    float run = 0.f;
#pragma unroll
    for (int s = 0; s < 16; ++s) { run += lf[s]; Bc[(part * 16 + s) * 128 + d] = run; }
    Tot[part * 128 + d] = run;
    __syncthreads();
    float off = 0.f;
#pragma unroll
    for (int p = 0; p < 3; ++p) if (p < part) off += Tot[p * 128 + d];
#pragma unroll
    for (int s = 0; s < 16; ++s) Bc[(part * 16 + s) * 128 + d] += off;
    __syncthreads();
}
struct H1Regs { u32x4 k[2], v[2]; float lf[16]; };
__device__ __forceinline__ void h1_load(const Args& A, int item, int tid, H1Regs& R) {
    const int bh = item >> 7, c = item & 127, b = bh >> 2, h = bh & 3; const size_t row0 = (size_t)b * SEQ + c * 64;
#pragma unroll
    for (int a = 0; a < 2; ++a) { const int i = tid + a * NTHR; const int s = i >> 4, ch = i & 15, d0 = ch * 8;
        const bf16_t* p = WSP(bf16_t, WS_ZB) + (row0 + s) * ZW + h * 128 + d0; R.k[a] = *(const u32x4*)(p + ZHK); R.v[a] = *(const u32x4*)(p + ZHV); }
    { const float* src = WSP(float, WS_LF) + row0 * 512 + h * 128; const int d = tid & 127, part = tid >> 7;
#pragma unroll
      for (int s = 0; s < 16; ++s) R.lf[s] = src[(size_t)(part * 16 + s) * 512 + d]; }
}
__device__ __forceinline__ void h1_item(const Args& A, const Ctx& C, int item, int next_item, H1Regs& R, LAS unsigned char* lds) {
    const int bh = item >> 7, c = item & 127, b = bh >> 2, h = bh & 3; const size_t row0 = (size_t)b * SEQ + c * 64;
    LAS float* Bc = (LAS float*)(lds + H_BC); LAS float* Tot = (LAS float*)(lds + H_TOT);
    LAS bf16_t* KT = (LAS bf16_t*)(lds + H_A);
    LAS bf16_t* VT = KT + 128 * 72;
    int tid = C.tid, w = C.wave; asm volatile("" : "+v"(tid), "+s"(w)); const int lane = tid & 63, fr = lane & 15, fq = lane >> 4;
    __syncthreads();
    chunk_cumsum_regs(R.lf, Bc, Tot, tid);
#pragma unroll
    for (int a = 0; a < 2; ++a) { const int i = tid + a * NTHR; const int s = i >> 4, ch = i & 15, d0 = ch * 8;
        const u32x4 kk = R.k[a], vv = R.v[a];
        const unsigned kw[4] = {kk.x, kk.y, kk.z, kk.w}, vw[4] = {vv.x, vv.y, vv.z, vv.w};
#pragma unroll
        for (int e = 0; e < 8; ++e) { const int d = d0 + e; const float kf = (e & 1) ? bfhi(kw[e >> 1]) : bflo(kw[e >> 1]);
            const float kt = kf * __expf(Bc[63 * 128 + d] - Bc[s * 128 + d]);
            KT[d * 72 + s] = (bf16_t)f2bf(kt);
            VT[d * 72 + s] = (bf16_t)((e & 1) ? (vw[e >> 1] >> 16) : (vw[e >> 1] & 0xffffu)); } }
    __syncthreads();
    if (next_item >= 0) h1_load(A, next_item, tid, R);
    f32x4 acc[8];
#pragma unroll
    for (int j = 0; j < 8; ++j) acc[j] = (f32x4){0.f, 0.f, 0.f, 0.f};
#pragma unroll
    for (int k = 0; k < 2; ++k) { const bf16x8 av = ldfrag(VT, 72, 16 * w, 32 * k, lane);
#pragma unroll
        for (int j = 0; j < 8; ++j) { const bf16x8 bk = ldfrag(KT, 72, 16 * j, 32 * k, lane); acc[j] = MFMA16(av, bk, acc[j]); } }
    float* SLi = WSP(float, WS_SL) + (size_t)item * 16384;
#pragma unroll
    for (int j = 0; j < 8; ++j)
#pragma unroll
        for (int i = 0; i < 4; ++i) SLi[(16 * w + 4 * fq + i) * 128 + 16 * j + fr] = acc[j][i];
    if (tid < 128) WSP(float, WS_DC)[(size_t)item * 128 + tid] = __expf(Bc[63 * 128 + tid]);
}

__device__ __forceinline__ void conv_item(const Args& A, const Ctx& C, int l, int item, LAS unsigned char* lds) {
    const int b = item >> 7, tt = item & 127, t0 = tt * 64;
    LAS bf16_t* Us = (LAS bf16_t*)lds;
    LAS float* Ys = (LAS float*)(lds + 48128);
    int tid = C.tid, w = C.wave; asm volatile("" : "+v"(tid), "+s"(w)); const int lane = tid & 63;
    __syncthreads();
    for (int i = tid; i < 94 * 32; i += NTHR) { const int rr = i >> 5, ch = i & 31; const int t = t0 - 30 + rr;
        u32x4 v = (u32x4){0u, 0u, 0u, 0u};
        if (t >= 0) v = *(const u32x4*)(WSP(bf16_t, WS_ZB) + ((size_t)b * SEQ + t) * ZW + ch * 8);
        *(LAS u32x4*)(Us + rr * 256 + ch * 8) = v; }
    __syncthreads();
    {
        const int c = tid & 255, half = tid >> 8;
        const float* Wl = PIN(12) + (size_t)l * 31 * 256;
        float wv[31];
#pragma unroll
        for (int k = 0; k < 31; ++k) wv[k] = Wl[k * 256 + c];
        const float bias = PIN(13)[l * 256 + c];
        float acc[32];
#pragma unroll
        for (int k = 0; k < 32; ++k) acc[k] = bias;
#pragma unroll
        for (int i = 0; i < 62; ++i) {
            const float x = bf2f(Us[(half * 32 + i) * 256 + c]);
#pragma unroll
            for (int k = 0; k < 32; ++k) { if (i - k >= 0 && i - k <= 30) acc[k] += wv[i - k] * x; }
        }
#pragma unroll
        for (int k = 0; k < 32; ++k) Ys[(half * 32 + k) * 257 + c] = acc[k];
    }
    __syncthreads();
    {
        const float* gl = PIN(14) + l * 256; const float* bl = PIN(15) + l * 256;
        float gg[4], bb[4];
#pragma unroll
        for (int j = 0; j < 4; ++j) { gg[j] = gl[lane + 64 * j]; bb[j] = bl[lane + 64 * j]; }
        for (int k = 0; k < 8; ++k) {
            const int tl = w * 8 + k; float v[4]; float s = 0.f;
#pragma unroll
            for (int j = 0; j < 4; ++j) { v[j] = Ys[tl * 257 + lane + 64 * j]; s += v[j]; }
            const float mean = wave_sum(s) * (1.f / 256.f); float q = 0.f;
#pragma unroll
            for (int j = 0; j < 4; ++j) { v[j] -= mean; q += v[j] * v[j]; }
            const float rstd = 1.0f / sqrtf(wave_sum(q) * (1.f / 256.f) + EPS);
            bf16_t* yo = WSP(bf16_t, WS_Y) + ((size_t)b * SEQ + t0 + tl) * DM;
#pragma unroll
            for (int j = 0; j < 4; ++j) yo[lane + 64 * j] = (bf16_t)f2bf(siluf_(v[j] * rstd * gg[j] + bb[j]));
        }
    }
    if (tt == 127) {
        float* oc = POUT + O_CP + (size_t)(l * 2 + b) * 30 * 256;
        for (int i = tid; i < 30 * 256; i += NTHR) oc[i] = bf2f(Us[64 * 256 + i]);
    }
}
__device__ __forceinline__ void conv_sample_item(const Args& A, const Ctx& C, int l, int b, LAS unsigned char* lds) {
    LAS float* Fs = (LAS float*)lds;
    LAS float* Ys = (LAS float*)(lds + 34816);
    int tid = C.tid, w = C.wave; asm volatile("" : "+v"(tid), "+s"(w)); const int lane = tid & 63;
    __syncthreads();
    const float* st = PIN(2) + (size_t)(l * DB + b) * 30 * 256;
    for (int i = tid; i < 30 * 256; i += NTHR) Fs[i] = st[i];
    for (int i = tid; i < 4 * 256; i += NTHR) Fs[30 * 256 + i] = bf2f(WSP(bf16_t, WS_ZB)[((size_t)MP + 4 * b + (i >> 8)) * ZW + (i & 255)]);
    __syncthreads();
    {
        const int c = tid & 255, half = tid >> 8;
        const float* Wl = PIN(12) + (size_t)l * 31 * 256;
        const float bias = PIN(13)[l * 256 + c];
        float a0 = bias, a1 = bias;
#pragma unroll
        for (int k = 0; k < 31; ++k) { const float wk = Wl[k * 256 + c]; a0 += wk * Fs[(2 * half + k) * 256 + c]; a1 += wk * Fs[(2 * half + 1 + k) * 256 + c]; }
        Ys[(2 * half) * 257 + c] = a0; Ys[(2 * half + 1) * 257 + c] = a1;
    }
    __syncthreads();
    if (w < 4) {
        const float* gl = PIN(14) + l * 256; const float* bl = PIN(15) + l * 256;
        float v[4]; float s = 0.f;
#pragma unroll
        for (int j = 0; j < 4; ++j) { v[j] = Ys[w * 257 + lane + 64 * j]; s += v[j]; }
        const float mean = wave_sum(s) * (1.f / 256.f); float q = 0.f;
#pragma unroll
        for (int j = 0; j < 4; ++j) { v[j] -= mean; q += v[j] * v[j]; }
        const float rstd = 1.0f / sqrtf(wave_sum(q) * (1.f / 256.f) + EPS);
        bf16_t* yo = WSP(bf16_t, WS_Y) + ((size_t)MP + 4 * b + w) * DM;
#pragma unroll
        for (int j = 0; j < 4; ++j) yo[lane + 64 * j] = (bf16_t)f2bf(siluf_(v[j] * rstd * gl[lane + 64 * j] + bl[lane + 64 * j]));
    }
    float* oc = POUT + O_CS + (size_t)(l * DB + b) * 30 * 256;
    for (int i = tid; i < 30 * 256; i += NTHR) oc[i] = Fs[4 * 256 + i];
}
__device__ __forceinline__ void attn_sample_item(const Args& A, const Ctx& C, int l, int item, LAS unsigned char* lds) {
    int tid = C.tid, w = C.wave; asm volatile("" : "+v"(tid), "+s"(w)); const int lane = tid & 63;
    const int pair = (w >= 3) ? ((w >= 6) ? 2 : 1) : 0, br = w - 3 * pair; const bool active = w < 6;
    const int idx = item * 2 + (active ? pair : 0); const int b = idx >> 4, t = (idx >> 2) & 3, h = idx & 3;
    LAS float* qs = (LAS float*)(lds + w * 1024);
    LAS float* ps = qs + 64;
    LAS float* res = (LAS float*)(lds + 8192);
    __syncthreads();
    const size_t srow = (size_t)MP + 4 * b + t;
    if (active) {
        qs[lane] = bf2f(WSP(bf16_t, WS_ZB)[srow * ZW + ZQ + h * 64 + lane]);
        LDS_FENCE();
        const float slope = exp2f(-2.f * (float)(h + 1));
        const float* ck = PIN(3) + (size_t)(l * DB + b) * 2048 * 256 + h * 64;
        const float* cv = PIN(4) + (size_t)(l * DB + b) * 2048 * 256 + h * 64;
        const int sh = 2 * br;
        float sc[3];
#pragma unroll
        for (int jj = 0; jj < 3; ++jj) {
            const int j = lane + 64 * jj; float sv = -1e30f;
            if (j <= 128) {
                const int ix = 2048 + t - (j << sh); float dot = 0.f;
                if (ix < 2048) { const f32x4* kp = (const f32x4*)(ck + (size_t)ix * 256);
#pragma unroll
                    for (int c4 = 0; c4 < 16; ++c4) { const f32x4 kv = kp[c4]; const f32x4 qv = *(const LAS f32x4*)(qs + 4 * c4); dot += (kv.x * qv.x + kv.y * qv.y) + (kv.z * qv.z + kv.w * qv.w); } }
                else { const bf16_t* kp = WSP(bf16_t, WS_ZB) + ((size_t)MP + 4 * b + (ix - 2048)) * ZW + ZK + h * 64;
#pragma unroll 8
                    for (int d = 0; d < 64; ++d) dot += bf2f(kp[d]) * qs[d]; }
                sv = dot - slope * (float)(j << sh);
            }
            sc[jj] = sv;
            if (jj == 1) asm volatile("" ::: "memory");
        }
        const float m = wave_max(fmaxf(fmaxf(sc[0], sc[1]), sc[2]));
        float lsum = 0.f;
#pragma unroll
        for (int jj = 0; jj < 3; ++jj) { const float p = __expf(sc[jj] - m); lsum += p; ps[lane + 64 * jj] = p; }
        lsum = wave_sum(lsum);
        LDS_FENCE();
        f32x4 o = (f32x4){0.f, 0.f, 0.f, 0.f};
        const int kg = lane >> 4, c4 = lane & 15;
#pragma unroll 11
        for (int j0 = 0; j0 < 132; j0 += 4) {
            const int j = j0 + kg;
            if (j <= 128) {
                const int ix = 2048 + t - (j << sh); f32x4 v;
                if (ix < 2048) v = *(const f32x4*)(cv + (size_t)ix * 256 + c4 * 4);
                else { const u32x2 r2 = *(const u32x2*)(WSP(bf16_t, WS_ZB) + ((size_t)MP + 4 * b + (ix - 2048)) * ZW + ZV + h * 64 + c4 * 4); v = (f32x4){bflo(r2.x), bfhi(r2.x), bflo(r2.y), bfhi(r2.y)}; }
                o += v * ps[j];
            }
        }
#pragma unroll
        for (int e = 0; e < 4; ++e) { o[e] += __shfl_xor(o[e], 16); o[e] += __shfl_xor(o[e], 32); }
        LAS float* rp = res + (pair * 3 + br) * 68;
        if (lane < 16) *(LAS f32x4*)(rp + 4 + lane * 4) = o;
        if (lane == 0) { rp[0] = m; rp[1] = lsum; }
    }
    __syncthreads();
    if (active && br == 0 && lane < 16) {
        const LAS float* r0 = res + (pair * 3) * 68; const LAS float* r1 = r0 + 68; const LAS float* r2 = r0 + 136;
        const float M = fmaxf(r0[0], fmaxf(r1[0], r2[0])); const float w0 = __expf(r0[0] - M), w1 = __expf(r1[0] - M), w2 = __expf(r2[0] - M);
        const float inv = 1.f / (r0[1] * w0 + r1[1] * w1 + r2[1] * w2);
        const f32x4 O = (*(const LAS f32x4*)(r0 + 4 + lane * 4) * w0 + *(const LAS f32x4*)(r1 + 4 + lane * 4) * w1 + *(const LAS f32x4*)(r2 + 4 + lane * 4) * w2) * inv;
        u32x2 wv; wv.x = pk2(O.x, O.y); wv.y = pk2(O.z, O.w);
        *(u32x2*)(WSP(bf16_t, WS_Y) + srow * DM + 256 + h * 64 + lane * 4) = wv;
    }
}
__device__ __forceinline__ void hgrn_sample_item(const Args& A, const Ctx& C, int l, int item, LAS unsigned char* lds) {
    const int b = item >> 2, h = item & 3; int tid = C.tid, w = C.wave; asm volatile("" : "+v"(tid), "+s"(w)); const int lane = tid & 63;
    LAS float* fs = (LAS float*)lds;
    LAS float* ks = fs + 512;
    LAS float* qq = ks + 512;
    LAS float* red = qq + 512;
    __syncthreads();
    { const int t = tid >> 7, d = tid & 127; const size_t row = (size_t)MP + 4 * b + t;
      fs[tid] = __expf(WSP(float, WS_LF)[row * 512 + h * 128 + d]); ks[tid] = bf2f(WSP(bf16_t, WS_ZB)[row * ZW + ZHK + h * 128 + d]); qq[tid] = bf2f(WSP(bf16_t, WS_ZB)[row * ZW + ZHQ + h * 128 + d]); }
    __syncthreads();
    const int v = tid & 127, dq = tid >> 7;
    const float* S0 = PIN(5) + (size_t)((l * DB + b) * 4 + h) * 16384;
    float S[32];
#pragma unroll
    for (int j = 0; j < 32; ++j) S[j] = S0[(dq * 32 + j) * 128 + v];
#pragma unroll
    for (int t = 0; t < 4; ++t) {
        const float vt = bf2f(WSP(bf16_t, WS_ZB)[((size_t)MP + 4 * b + t) * ZW + ZHV + h * 128 + v]);
        float op = 0.f;
#pragma unroll
        for (int j = 0; j < 32; ++j) { const int d = dq * 32 + j; S[j] = fs[t * 128 + d] * S[j] + ks[t * 128 + d] * vt; op += S[j] * qq[t * 128 + d]; }
        red[(t * 4 + dq) * 128 + v] = op;
    }
    float* So = POUT + O_HS + (size_t)((l * DB + b) * 4 + h) * 16384;
#pragma unroll
    for (int j = 0; j < 32; ++j) So[(dq * 32 + j) * 128 + v] = S[j];
    __syncthreads();
    if (w < 4) {
        const int t = w; const size_t row = (size_t)MP + 4 * b + t; const float* gn = PIN(17) + l * 128;
        float o[2]; float ss = 0.f;
#pragma unroll
        for (int j = 0; j < 2; ++j) { const int vv = lane + 64 * j; o[j] = red[(t * 4 + 0) * 128 + vv] + red[(t * 4 + 1) * 128 + vv] + red[(t * 4 + 2) * 128 + vv] + red[(t * 4 + 3) * 128 + vv]; ss += o[j] * o[j]; }
        const float rstd = 1.0f / sqrtf(wave_sum(ss) * (1.f / 128.f) + EPS);
#pragma unroll
        for (int j = 0; j < 2; ++j) { const int vv = lane + 64 * j; const float g = bf2f(WSP(bf16_t, WS_ZB)[row * ZW + ZHG + h * 128 + vv]);
            WSP(bf16_t, WS_Y)[row * DM + 512 + h * 128 + vv] = (bf16_t)f2bf(o[j] * rstd * gn[vv] * g); }
    }
}

#ifdef PROFILE_SIDE
#define MSTAMP(k) do { __syncthreads(); if (C.bid == 0 && C.tid == 0) { LAS unsigned* prof = (LAS unsigned*)(lds + 151040); const unsigned tn = (unsigned)__builtin_amdgcn_s_memrealtime(); prof[k] += tn - prof[15]; prof[15] = tn; } } while (0)
#else
#define MSTAMP(k) do {} while (0)
#endif
constexpr int NA_ATT = 1536, NA_H1 = 1024, NA_CONV = 256, NA_SATT = 256, NA_SCONV = 32, NA_SHG = 128;
constexpr int NA_TOTAL = NA_ATT + NA_H1 + NA_CONV + NA_SATT + NA_SCONV + NA_SHG;
__device__ __forceinline__ void mixerA_phase(const Args& A, const Ctx& C, int l, LAS unsigned char* lds) {
    int t0_ = C.tid; asm volatile("" : "+v"(t0_));
    { AttnRegs R = {}; int it = C.bid; if (it < NA_ATT) attn_load(A, it, t0_, R);
      for (; it < NA_ATT; it += C.G) attn_item(A, C, it, (it + C.G < NA_ATT) ? it + C.G : -1, R, lds); }
    { H1Regs R = {}; int it = C.bid; if (it < NA_H1) h1_load(A, it, t0_, R);
      for (; it < NA_H1; it += C.G) h1_item(A, C, it, (it + C.G < NA_H1) ? it + C.G : -1, R, lds); }
    for (int it = C.bid; it < NA_CONV; it += C.G) conv_item(A, C, l, it, lds);
    for (int it = C.bid; it < NA_SATT; it += C.G) attn_sample_item(A, C, l, it, lds);
    for (int it = C.bid; it < NA_SCONV; it += C.G) conv_sample_item(A, C, l, it, lds);
    for (int it = C.bid - NA_SCONV; it < NA_SHG; it += C.G) { if (it >= 0) hgrn_sample_item(A, C, l, it, lds); }
    __syncthreads();
}

__device__ __forceinline__ void mixerB_phase(const Args& A, const Ctx& C, int l) {
    int tid_ = C.tid; asm volatile("" : "+v"(tid_));
    const int gt = C.bid * NTHR + tid_, NGT = C.G * NTHR;
    for (int e = gt; e < 8 * 16384; e += NGT) {
        const int bh = e >> 14, vd = e & 16383, d = vd & 127, v = vd >> 7;
        float S = 0.f;
        const float* sl = WSP(float, WS_SL) + (size_t)bh * 128 * 16384 + vd; const float* dc = WSP(float, WS_DC) + (size_t)bh * 128 * 128 + d; bf16_t* sp = WSP(bf16_t, WS_SP) + (size_t)bh * 128 * 16384 + vd;
#pragma unroll 1
        for (int c0 = 0; c0 < 128; c0 += 32) {
            float slv[32], dcv[32];
#pragma unroll
            for (int k = 0; k < 32; ++k) { slv[k] = sl[(size_t)(c0 + k) * 16384]; dcv[k] = dc[(c0 + k) * 128]; }
#pragma unroll
            for (int k = 0; k < 32; ++k) { sp[(size_t)(c0 + k) * 16384] = (bf16_t)f2bf(S); S = dcv[k] * S + slv[k]; }
        }
        POUT[O_HP + (size_t)(l * 8 + bh) * 16384 + d * 128 + v] = S;
    }
    for (int i = gt; i < MP * 64; i += NGT) {
        const int row = i >> 6, c4 = i & 63, h = c4 >> 4;
        const float l0 = WSP(float, WS_LSE)[(size_t)row * 4 + h], l1 = WSP(float, WS_LSE)[(size_t)(MP + row) * 4 + h], l2 = WSP(float, WS_LSE)[(size_t)(2 * MP + row) * 4 + h];
        const float m = fmaxf(l0, fmaxf(l1, l2)); float w0 = __expf(l0 - m), w1 = __expf(l1 - m), w2 = __expf(l2 - m);
        const float inv = 1.f / (w0 + w1 + w2); w0 *= inv; w1 *= inv; w2 *= inv;
        const f32x4 a = *(const f32x4*)(WSP(float, WS_OP) + (size_t)row * 256 + c4 * 4), bq = *(const f32x4*)(WSP(float, WS_OP) + ((size_t)MP + row) * 256 + c4 * 4), cq = *(const f32x4*)(WSP(float, WS_OP) + ((size_t)2 * MP + row) * 256 + c4 * 4);
        const f32x4 y = a * w0 + bq * w1 + cq * w2;
        u32x2 wv; wv.x = pk2(y.x, y.y); wv.y = pk2(y.z, y.w);
        *(u32x2*)(WSP(bf16_t, WS_Y) + (size_t)row * DM + 256 + c4 * 4) = wv;
    }
}

constexpr int H3_QH = 34816, H3_KH = 52224, H3_QT = 69632, H3_VT = 87040, H3_ST = 105472, H3_P = 140288, H3_RED = 149504;
struct H3Regs { u32x4 q[2], k[2], v[2], s[4]; float lf[16]; };
__device__ __forceinline__ void h3_load(const Args& A, int item, int tid, H3Regs& R) {
    const int bh = item >> 7, c = item & 127, b = bh >> 2, h = bh & 3; const size_t row0 = (size_t)b * SEQ + c * 64;
#pragma unroll
    for (int a = 0; a < 2; ++a) { const int i = tid + a * NTHR; const int s = i >> 4, ch = i & 15, d0 = ch * 8;
        const bf16_t* p = WSP(bf16_t, WS_ZB) + (row0 + s) * ZW + h * 128 + d0; R.q[a] = *(const u32x4*)(p + ZHQ); R.k[a] = *(const u32x4*)(p + ZHK); R.v[a] = *(const u32x4*)(p + ZHV); }
    { const bf16_t* sp = WSP(bf16_t, WS_SP) + (size_t)item * 16384;
#pragma unroll
      for (int a = 0; a < 4; ++a) { const int i = tid + a * NTHR; const int v = i >> 4, ch = i & 15; R.s[a] = *(const u32x4*)(sp + v * 128 + ch * 8); } }
    { const float* src = WSP(float, WS_LF) + row0 * 512 + h * 128; const int d = tid & 127, part = tid >> 7;
#pragma unroll
      for (int s = 0; s < 16; ++s) R.lf[s] = src[(size_t)(part * 16 + s) * 512 + d]; }
}
__device__ __forceinline__ void h3_item(const Args& A, const Ctx& C, int l, int item, int next_item, H3Regs& R, LAS unsigned char* lds) {
    const int bh = item >> 7, c = item & 127, b = bh >> 2, h = bh & 3; const size_t row0 = (size_t)b * SEQ + c * 64;
    LAS float* Bc = (LAS float*)(lds + H_BC); LAS float* Tot = (LAS float*)(lds + H_TOT);
    LAS bf16_t* Qh = (LAS bf16_t*)(lds + H3_QH); LAS bf16_t* Kh = (LAS bf16_t*)(lds + H3_KH); LAS bf16_t* Qt = (LAS bf16_t*)(lds + H3_QT);
    LAS bf16_t* VT = (LAS bf16_t*)(lds + H3_VT);
    LAS bf16_t* ST = (LAS bf16_t*)(lds + H3_ST);
    LAS bf16_t* P = (LAS bf16_t*)(lds + H3_P);
    LAS float* red = (LAS float*)(lds + H3_RED);
    int tid = C.tid, w = C.wave; asm volatile("" : "+v"(tid), "+s"(w)); const int lane = tid & 63, fr = lane & 15, fq = lane >> 4;
    __syncthreads();
    chunk_cumsum_regs(R.lf, Bc, Tot, tid);
#pragma unroll
    for (int a = 0; a < 2; ++a) { const int i = tid + a * NTHR; const int s = i >> 4, ch = i & 15, d0 = ch * 8;
        const u32x4 qv = R.q[a], kk = R.k[a], vv = R.v[a];
        const unsigned qw[4] = {qv.x, qv.y, qv.z, qv.w}, kw[4] = {kk.x, kk.y, kk.z, kk.w}, vw[4] = {vv.x, vv.y, vv.z, vv.w};
        float qh[8], kh[8], qt[8];
#pragma unroll
        for (int e = 0; e < 8; ++e) { const int d = d0 + e; const float qf = (e & 1) ? bfhi(qw[e >> 1]) : bflo(qw[e >> 1]); const float kf = (e & 1) ? bfhi(kw[e >> 1]) : bflo(kw[e >> 1]);
            const float bt = Bc[s * 128 + d], bm = Bc[31 * 128 + d];
            qh[e] = qf * __expf(bt - bm); kh[e] = kf * __expf(bm - bt); qt[e] = qf * __expf(bt);
            VT[d * 72 + s] = (bf16_t)((e & 1) ? (vw[e >> 1] >> 16) : (vw[e >> 1] & 0xffffu)); }
        u32x4 o;
        o.x = pk2(qh[0], qh[1]); o.y = pk2(qh[2], qh[3]); o.z = pk2(qh[4], qh[5]); o.w = pk2(qh[6], qh[7]); *(LAS u32x4*)(Qh + s * 136 + d0) = o;
        o.x = pk2(kh[0], kh[1]); o.y = pk2(kh[2], kh[3]); o.z = pk2(kh[4], kh[5]); o.w = pk2(kh[6], kh[7]); *(LAS u32x4*)(Kh + s * 136 + d0) = o;
        o.x = pk2(qt[0], qt[1]); o.y = pk2(qt[2], qt[3]); o.z = pk2(qt[4], qt[5]); o.w = pk2(qt[6], qt[7]); *(LAS u32x4*)(Qt + s * 136 + d0) = o; }
#pragma unroll
    for (int a = 0; a < 4; ++a) { const int i = tid + a * NTHR; const int v = i >> 4, ch = i & 15; *(LAS u32x4*)(ST + v * 136 + ch * 8) = R.s[a]; }
    __syncthreads();
    const int ti = w >> 1;
    unsigned short gst[4][4];
#pragma unroll
    for (int i = 0; i < 4; ++i)
#pragma unroll
        for (int j = 0; j < 4; ++j) gst[i][j] = WSP(bf16_t, WS_ZB)[(row0 + 16 * ti + 4 * fq + i) * ZW + ZHG + h * 128 + 16 * (4 * (w & 1) + j) + fr];
    if (next_item >= 0) h3_load(A, next_item, tid, R);
    {
        const int si0 = 2 * (w & 1);
#pragma unroll
        for (int sj = 0; sj < 2; ++sj) { const int si = si0 + sj; f32x4 a = (f32x4){0.f, 0.f, 0.f, 0.f};
#pragma unroll
            for (int k = 0; k < 4; ++k) { const bf16x8 fa = ldfrag(Qh, 136, 16 * ti, 32 * k, lane), fb = ldfrag(Kh, 136, 16 * si, 32 * k, lane); a = MFMA16(fa, fb, a); }
#pragma unroll
            for (int i = 0; i < 4; ++i) { const int t = 16 * ti + 4 * fq + i, s = 16 * si + fr; const float pv = (s <= t) ? a[i] : 0.f; P[t * 72 + s] = (bf16_t)f2bf(pv); } }
    }
    __syncthreads();
    f32x4 acc[4];
    const int vt0 = 4 * (w & 1);
#pragma unroll
    for (int j = 0; j < 4; ++j) acc[j] = (f32x4){0.f, 0.f, 0.f, 0.f};
#pragma unroll
    for (int k = 0; k < 2; ++k) { const bf16x8 fa = ldfrag(P, 72, 16 * ti, 32 * k, lane);
#pragma unroll
        for (int j = 0; j < 4; ++j) { const bf16x8 fb = ldfrag(VT, 72, 16 * (vt0 + j), 32 * k, lane); acc[j] = MFMA16(fa, fb, acc[j]); } }
#pragma unroll
    for (int k = 0; k < 4; ++k) { const bf16x8 fa = ldfrag(Qt, 136, 16 * ti, 32 * k, lane);
#pragma unroll
        for (int j = 0; j < 4; ++j) { const bf16x8 fb = ldfrag(ST, 136, 16 * (vt0 + j), 32 * k, lane); acc[j] = MFMA16(fa, fb, acc[j]); } }
    float ss[4];
#pragma unroll
    for (int i = 0; i < 4; ++i) { float q = 0.f;
#pragma unroll
        for (int j = 0; j < 4; ++j) q += acc[j][i] * acc[j][i];
        ss[i] = sum16(q); }
    if (fr == 0) {
#pragma unroll
        for (int i = 0; i < 4; ++i) red[(w & 1) * 64 + 16 * ti + 4 * fq + i] = ss[i];
    }
    __syncthreads();
    const float* gn = PIN(17) + l * 128;
#pragma unroll
    for (int i = 0; i < 4; ++i) { const int t = 16 * ti + 4 * fq + i; const float rstd = 1.0f / sqrtf((red[t] + red[64 + t]) * (1.f / 128.f) + EPS);
        const size_t row = row0 + t;
#pragma unroll
        for (int j = 0; j < 4; ++j) { const int v = 16 * (vt0 + j) + fr; const float g = bf2f(gst[i][j]);
            WSP(bf16_t, WS_Y)[row * DM + 512 + h * 128 + v] = (bf16_t)f2bf(acc[j][i] * rstd * gn[v] * g); } }
}

#define XB_TMO      128
#define XB_XCNT(j)  (256  + 64 * (j))
#define XB_XSUB(j)  (1280 + 64 * (j))
#define XB_XGEN(j)  (2304 + 64 * (j))
#define XB_TOP      3328
#define XB_TOPGEN   3392
#define XCD_BAR_WORDS 3456
#define XB_SPIN_CAP (1u << 18)

__device__ __forceinline__ unsigned xb_ld(unsigned* p)              { return __hip_atomic_load(p, __ATOMIC_RELAXED, __HIP_MEMORY_SCOPE_AGENT); }
__device__ __forceinline__ unsigned xb_add(unsigned* p, unsigned v) { return __hip_atomic_fetch_add(p, v, __ATOMIC_RELAXED, __HIP_MEMORY_SCOPE_AGENT); }
__device__ __forceinline__ unsigned xb_xcc_id() { return (unsigned)__builtin_amdgcn_s_getreg((3 << 11) | 20) & 0xFu; }
#define XB_SPIN(cond, bar) do { unsigned _sp = 0; while (cond) { __builtin_amdgcn_s_sleep(1); \
    if ((++_sp & 255u) == 0u) { if (xb_ld(&(bar)[XB_TMO])) break; if (_sp > XB_SPIN_CAP) { atomicAdd(&(bar)[XB_TMO], 1u); break; } } } } while (0)

struct XcdBarrier {
    unsigned* bar; unsigned x;
    volatile LAS unsigned* st;
};

__device__ __forceinline__ XcdBarrier xcd_barrier_post(unsigned* bar, volatile LAS unsigned* st) {
    XcdBarrier b; b.bar = bar; b.x = xb_xcc_id(); b.st = st;
    if (threadIdx.x == 0) (void)xb_add(&bar[XB_XCNT(b.x)], 1u);
    return b;
}
__device__ __forceinline__ void xcd_barrier_complete(unsigned* bar, unsigned x, unsigned& nloc, unsigned& nx) {
    const unsigned G = gridDim.x * gridDim.y * gridDim.z;
    unsigned sum, cnt, mine, sp = 0u;
    for (;;) {
        sum = 0u; cnt = 0u; mine = 0u;
#pragma unroll
        for (unsigned j = 0; j < 16; ++j) { const unsigned c = xb_ld(&bar[XB_XCNT(j)]); sum += c; cnt += (c > 0u) ? 1u : 0u; mine = (j == x) ? c : mine; }
        if (sum == G) break;
        __builtin_amdgcn_s_sleep(1);
        if ((++sp & 255u) == 0u) { if (xb_ld(&bar[XB_TMO])) break; if (sp > XB_SPIN_CAP) { atomicAdd(&bar[XB_TMO], 1u); break; } }
    }
    nloc = mine > 0u ? mine : 1u; nx = cnt > 0u ? cnt : 1u;
}

__device__ __forceinline__ void xcd_barrier(const XcdBarrier& b) {
    asm volatile("s_waitcnt vmcnt(0)" ::: "memory");
    __syncthreads();
    unsigned tx_ = threadIdx.x; asm volatile("" : "+v"(tx_));
    if (tx_ == 0) {
        unsigned* bar = b.bar; unsigned bx_ = b.x; asm volatile("" : "+s"(bar), "+s"(bx_));
        __builtin_amdgcn_s_waitcnt(0);
        unsigned nloc = b.st[0], nx = b.st[1];
        if (nloc == 0u) { xcd_barrier_complete(bar, bx_, nloc, nx); b.st[0] = nloc; b.st[1] = nx; }
        const unsigned old = xb_add(&bar[XB_XSUB(bx_)], 1u);
        const unsigned gen = old / nloc;
        if (old + 1u == (gen + 1u) * nloc) {
            __builtin_amdgcn_fence(__ATOMIC_RELEASE, "agent");
            asm volatile("s_waitcnt vmcnt(0)" ::: "memory");
            const unsigned og = xb_add(&bar[XB_TOP], 1u);
            const unsigned tg = og / nx;
            if (og + 1u == (tg + 1u) * nx) xb_add(&bar[XB_TOPGEN], 1u);
            else XB_SPIN(xb_ld(&bar[XB_TOPGEN]) == tg, bar);
            __builtin_amdgcn_fence(__ATOMIC_ACQUIRE, "agent");
            xb_add(&bar[XB_XGEN(bx_)], 1u);
            asm volatile("s_waitcnt vmcnt(0)" ::: "memory");
        } else {
            XB_SPIN(xb_ld(&bar[XB_XGEN(bx_)]) == gen, bar);
            __builtin_amdgcn_fence(__ATOMIC_ACQUIRE, "agent");
            asm volatile("s_waitcnt vmcnt(0)" ::: "memory");
        }
    }
    __syncthreads();
}

__global__ void __launch_bounds__(NTHR, 2) fwd_megakernel(Args args) {
    cg::grid_group grid = cg::this_grid();
    LAS unsigned char* lds = (LAS unsigned char*)lds_raw;
    const Args& A = args;
    if (threadIdx.x < 26) ((LAS unsigned long long*)((LAS unsigned char*)lds_raw + PT_OFF))[threadIdx.x] = ((const unsigned long long*)&args)[threadIdx.x];
    if (threadIdx.x >= 32 && threadIdx.x < 36) ((LAS unsigned*)((LAS unsigned char*)lds_raw + PT_OFF + 256))[threadIdx.x - 32] = 0u;
    __syncthreads();
    XcdBarrier xbar = xcd_barrier_post((unsigned*)(args.ws + WS_BAR), (volatile LAS unsigned*)((LAS unsigned char*)lds_raw + PT_OFF + 256));
    Ctx C;
    C.tid = threadIdx.x; C.wave = __builtin_amdgcn_readfirstlane(C.tid >> 6); C.G = gridDim.x; C.bid = blockIdx.x;

#ifndef NO_PRO
    prologue_phase(A, C, lds);
#endif
    if (args.ws == nullptr) grid.sync();
    xcd_barrier(xbar);
#ifdef PROFILE_SIDE
    LAS unsigned* prof = (LAS unsigned*)(lds + 151040);
    if (C.bid == 0 && C.tid == 0) { for (int k = 0; k < 16; ++k) prof[k] = 0; prof[15] = (unsigned)__builtin_amdgcn_s_memrealtime(); prof[14] = prof[15]; }
#define PSTAMP(k) do { if (C.bid == 0 && C.tid == 0) { const unsigned tn = (unsigned)__builtin_amdgcn_s_memrealtime(); prof[k] += tn - prof[15]; prof[15] = tn; } } while (0)
#else
#define PSTAMP(k) do {} while (0)
#endif
#pragma unroll 1
    for (int l = 0; l < DEPTH; ++l) {
#pragma unroll 1
        for (int f = 0; f < 2; ++f) {
            if (f == 1) {
                norm_phase<0>(A, C, PIN(10) + l * DM, 11);
                xcd_barrier(xbar); PSTAMP(1);
                {
                    pg8::Gemm g{WSP(bf16_t, WS_XN), (const bf16_t*)(PWS + WS_WIN + (size_t)l * SZ_WIN), MPAD, NIN, DM}; pg8::StaticOrder S; S.init(MPAD, NIN, C.G, C.bid, DM);
                    EpiWin E{WSP(bf16_t, WS_ZB), WSP(float, WS_LF), WSP(float, WS_LB) + l * 512, POUT + O_KP + (size_t)l * 2 * 2048 * 256, POUT + O_VP + (size_t)l * 2 * 2048 * 256,
                             POUT + O_KS + (size_t)l * MS * 256, POUT + O_VS + (size_t)l * MS * 256};

#ifndef NO_GWIN
 pg8::gemm_phase<EpiWin, pg8::StaticOrder, true, true>(lds, g, S, E);
#endif

                }
                xcd_barrier(xbar); PSTAMP(4);
#ifndef NO_MA
                mixerA_phase(A, C, l, lds);
#endif
                xcd_barrier(xbar); PSTAMP(5);
#ifndef NO_MB
                mixerB_phase(A, C, l);
#endif
                xcd_barrier(xbar); PSTAMP(6);
#ifndef NO_MC
                { H3Regs R = {}; int it = C.bid; int t0_ = C.tid; asm volatile("" : "+v"(t0_)); if (it < 1024) h3_load(A, it, t0_, R);
                  for (; it < 1024; it += C.G) h3_item(A, C, l, it, (it + C.G < 1024) ? it + C.G : -1, R, lds); }
#endif
                __syncthreads();
                xcd_barrier(xbar); PSTAMP(7);
                {
                    pg8::Gemm g{WSP(bf16_t, WS_Y), (const bf16_t*)(PWS + WS_WO + (size_t)l * SZ_WO), MPAD, DM, DM}; pg8::SplitOrder S; S.init(MP, DM, C.G, C.bid, DM, 4);
                    EpiResid E{WSP(float, WS_X), WSP(float, WS_SL)};

#ifndef NO_GRES
 pg8::gemm_phase<EpiResid, pg8::SplitOrder, false, true>(lds, g, S, E);
#endif

                }
                xcd_barrier(xbar); PSTAMP(8);
                norm_phase<0>(A, C, PIN(19) + l * DM, 4);
                xcd_barrier(xbar); PSTAMP(1);
            }
            {
                pg8::Gemm g{WSP(bf16_t, WS_XN), (const bf16_t*)(PWS + WS_WGU + (size_t)(l * 2 + f) * SZ_WGU), MPAD, 2 * FF, DM}; pg8::StaticOrder S; S.init(MPAD, 2 * FF, C.G, C.bid, DM);
                EpiSwiglu E{WSP(bf16_t, WS_ACT)};

#ifndef NO_GSW
 pg8::gemm_phase<EpiSwiglu, pg8::StaticOrder, true, true>(lds, g, S, E);
#endif

            }
            xcd_barrier(xbar); PSTAMP(2);
            {
                pg8::Gemm g{WSP(bf16_t, WS_ACT), (const bf16_t*)(PWS + WS_WD + (size_t)(l * 2 + f) * SZ_WD), MPAD, DM, FF}; pg8::SplitOrder S; S.init(MP, DM, C.G, C.bid, FF, 11);
                EpiResid E{WSP(float, WS_X), WSP(float, WS_SL)};

#ifndef NO_GRES
 pg8::gemm_phase<EpiResid, pg8::SplitOrder, false, true>(lds, g, S, E);
#endif

            }
            xcd_barrier(xbar); PSTAMP(3);
        }
        if (l + 1 < DEPTH) { norm_phase<0>(A, C, PIN(6) + (l + 1) * DM, 11); xcd_barrier(xbar); PSTAMP(1); }
    }
    norm_phase<2>(A, C, PIN(23), 11);
#ifdef PROFILE_SIDE
    xcd_barrier(xbar); PSTAMP(1);
    for (int q = 0; q < 16; ++q) xcd_barrier(xbar);
    PSTAMP(12);
    if (C.bid == 0 && C.tid == 0) {
        prof[9] = prof[15] - prof[14];
#pragma unroll 1
        for (int k = 1; k < 10; ++k) { const unsigned n = prof[k] / 100u;
            const size_t off = (k == 1) ? O_YS : (k == 2) ? O_CP : (k == 3) ? O_CS : (k == 4) ? O_KP : (k == 5) ? O_VP : (k == 6) ? O_KS : (k == 7) ? O_VS : (k == 8) ? O_HP : O_HS;
            for (unsigned i = 0; i < n && i < 60000u; ++i) ((unsigned*)POUT)[off + i] = 0xAAAAAAAAu; }
    }
#endif
}

extern "C" void kernel_launch(void* const* d_in, const int* in_sizes, int n_in, void* d_out, int out_size, void* d_ws, size_t ws_size, hipStream_t stream) {
    static int grid = 0;
    if (grid == 0) {
        if (n_in != 24 || (size_t)out_size != O_END || ws_size < WS_END) { fprintf(stderr, "kernel_launch: unexpected shapes: n_in %d out %d ws %zu (need %zu)\n", n_in, out_size, ws_size, (size_t)WS_END); grid = -1; return; }
        int dev = 0, cus = 0, per_cu = 0;
        hipGetDevice(&dev);
        hipDeviceGetAttribute(&cus, hipDeviceAttributeMultiprocessorCount, dev);
        if (hipFuncSetAttribute((const void*)fwd_megakernel, hipFuncAttributeMaxDynamicSharedMemorySize, LDS_BYTES) != hipSuccess) { fprintf(stderr, "kernel_launch: hipFuncSetAttribute failed\n"); grid = -1; return; }
        hipOccupancyMaxActiveBlocksPerMultiprocessor(&per_cu, (const void*)fwd_megakernel, NTHR, LDS_BYTES);
        if (per_cu < 1) { fprintf(stderr, "kernel_launch: occupancy query says %d blocks/CU\n", per_cu); per_cu = 1; }
        (void)hipGetLastError();
        grid = cus;
    }
    if (grid < 0) return;
    Args a{};
    for (int i = 0; i < 24; ++i) a.in[i] = (const float*)d_in[i];
    a.out = (float*)d_out; a.ws = (unsigned char*)d_ws;
    (void)hipMemsetAsync((unsigned char*)d_ws + WS_BAR, 0, WS_BAR_BYTES, stream);
    void* kargs[] = {&a};
    hipError_t e = hipLaunchCooperativeKernel((const void*)fwd_megakernel, dim3(grid), dim3(NTHR), kargs, LDS_BYTES, stream);
    if (e != hipSuccess) fprintf(stderr, "cooperative launch failed: %s (grid %d)\n", hipGetErrorString(e), grid);
}
```

```cpp
#include <hip/hip_runtime.h>
#include <hip/hip_cooperative_groups.h>
#include <cstdio>
#include <cstdint>
namespace cg = cooperative_groups;
namespace pg8 {
#define PG8_LAS __attribute__((address_space(3)))
typedef unsigned short bf16_t;
typedef short bf16x8 __attribute__((ext_vector_type(8)));
typedef float f32x4 __attribute__((ext_vector_type(4)));
typedef unsigned u32x4 __attribute__((ext_vector_type(4)));
constexpr int BM = 256, BK = 64, HALF = 128, HTB = HALF * BK * 2  , STAGE_BYTES = 8 * HTB, NXCD = 8, WGM = 8;

__host__ __device__ __forceinline__ int lds_byte(int r, int c) { const int st = (r >> 4) * 2 + (c >> 5), rr = r & 15, cc = c & 31, ob = rr * 64 + cc * 2; return st * 1024 + (ob ^ (((ob >> 9) & 1) << 5)); }
__host__ __device__ __forceinline__ void stage_rc(int b, int& R, int& C) { const int st = b / 1024, sb = b % 1024, swz = sb ^ (((sb >> 9) & 1) << 5); R = (st >> 1) * 16 + swz / 64; C = (st & 1) * 32 + (swz % 64) / 2; }
__host__ __device__ __forceinline__ int perm32(int rho) { const int n = rho >> 4, i = rho & 15; return 8 * (i >> 2) + 4 * n + (i & 3); }

struct Unit { int pm, pn, kt0, nt; };
struct Gemm { const bf16_t* A; const bf16_t* Bt; int M, N, K; };

struct StaticOrder {
    int nM, nN, nwg, G, c, ntk;
    __host__ __device__ __forceinline__ void init(int M, int N, int G_, int c_, int K_) { nM = M / BM; nN = N / BM; nwg = nM * nN; G = G_; c = c_; ntk = K_ / BK; }
    __host__ __device__ __forceinline__ void map(long L, int& pm, int& pn) const {
        int wgid = (int)L; { const int q = nwg / NXCD, r = nwg % NXCD, xcd = wgid % NXCD, off = wgid / NXCD; wgid = (xcd < r ? xcd * (q + 1) : r * (q + 1) + (xcd - r) * q) + off; }
        const int nig = WGM * nN, gid = wgid / nig, fm = gid * WGM, gsz = (nM - fm) < WGM ? (nM - fm) : WGM;
        pm = fm + ((wgid % nig) % gsz); pn = (wgid % nig) / gsz;
    }
    __host__ __device__ __forceinline__ bool next(int i, Unit& u) const {
        const long L = (long)i * G + c; const bool ok = L < nwg; int pm, pn; map(ok ? L : 0, pm, pn);
        u.pm = pm; u.pn = pn; u.kt0 = 0; u.nt = ntk; return ok;
    }
    __device__ __forceinline__ void a_ready(const Unit&) const {}
    __device__ __forceinline__ void done(const Unit&) const {}
};

struct SplitOrder {
    StaticOrder P; int nsplit;
    __host__ __device__ __forceinline__ void init(int Mp, int N, int G_, int c_, int K_, int nsplit_) { P.init(Mp, N, G_, c_, K_); nsplit = nsplit_; }
    __host__ __device__ __forceinline__ bool next(int i, Unit& u) const {
        const long L = (long)i * P.G + P.c; const bool samp = L >= P.nwg; const int j = samp ? (int)(L - P.nwg) : 0;
        int pm, pn; P.map(samp ? 0 : L, pm, pn);
        const int nts = P.ntk / nsplit;
        u.pm = samp ? P.nM : pm; u.pn = samp ? (j % P.nN) : pn; u.nt = samp ? nts : P.ntk; u.kt0 = samp ? (j / P.nN) * nts : 0;
        return L < (long)P.nwg + P.nN * nsplit;
    }
    __device__ __forceinline__ void a_ready(const Unit&) const {}
    __device__ __forceinline__ void done(const Unit&) const {}
};

__device__ __forceinline__ unsigned cvt_pk_bf16(float lo, float hi) { unsigned r; asm volatile("v_cvt_pk_bf16_f32 %0, %1, %2" : "=v"(r) : "v"(lo), "v"(hi)); return r; }
template <class Epi, class Sched, bool ALIGN_EPI = false, bool SP2 = false>
__device__ __forceinline__ void gemm_phase(PG8_LAS unsigned char* lds, const Gemm g, const Sched& S, const Epi& E) {
    int tid_ = threadIdx.x; asm volatile("" : "+v"(tid_));
    const int tid = tid_, wid = __builtin_amdgcn_readfirstlane(tid >> 6), lane = tid & 63, wr = wid >> 2, wc = wid & 3, fr = lane & 15, fq = lane >> 4;
    const int K = g.K;
    unsigned voffA[2], voffB[2];
#pragma unroll
    for (int i = 0; i < 2; ++i) { int R, C; stage_rc(tid * 16 + i * 8192, R, C); const int Rb = Epi::PERM ? ((R & ~31) + perm32(R & 31)) : R;
        voffA[i] = (unsigned)(R * K + C) * 2u; voffB[i] = (unsigned)(Rb * K + C) * 2u; }
    const size_t kstep = (size_t)(BK * 2);
    const size_t hstep = (size_t)HALF * K * 2;
    const size_t tstep = 2 * hstep;
    const unsigned ldsw = (unsigned)wid * 1024u;
    const int aoff = lds_byte(wr * 64 + fr, fq * 8), boff = lds_byte(wc * 32 + fr, fq * 8);
#define PG8_SA(b, h) (((b) * 2 + (h)) * HTB)
#define PG8_SB(b, h) ((4 + (b) * 2 + (h)) * HTB)
#define PG8_STAGE(bufoff, gbase, voff) do { _Pragma("unroll") for (int _i = 0; _i < 2; ++_i) \
        __builtin_amdgcn_global_load_lds((const unsigned*)((const char*)(gbase) + (voff)[_i]), (PG8_LAS unsigned*)(lds + (bufoff) + ldsw + _i * 8192), 16, 0, 0); } while (0)
#define PG8_LDA(dst, b, h) do { _Pragma("unroll") for (int m = 0; m < 4; ++m) _Pragma("unroll") for (int k = 0; k < 2; ++k) dst[m][k] = *(const PG8_LAS bf16x8*)(lds + PG8_SA(b, h) + aoff + m * 2048 + k * 1024); } while (0)
#define PG8_LDB(dst, b, h) do { _Pragma("unroll") for (int n = 0; n < 2; ++n) _Pragma("unroll") for (int k = 0; k < 2; ++k) dst[n][k] = *(const PG8_LAS bf16x8*)(lds + PG8_SB(b, h) + boff + n * 2048 + k * 1024); } while (0)
#define PG8_MMA(ai, bj, At, Bt) do { __builtin_amdgcn_s_setprio(1); _Pragma("unroll") for (int m = 0; m < 4; ++m) _Pragma("unroll") for (int n = 0; n < 2; ++n) _Pragma("unroll") for (int k = 0; k < 2; ++k) \
        acc[ai][bj][m][n] = __builtin_amdgcn_mfma_f32_16x16x32_bf16(Bt[n][k], At[m][k], acc[ai][bj][m][n], 0, 0, 0); __builtin_amdgcn_s_setprio(0); } while (0)
#define PG8_WAIT_V(n) asm volatile("s_waitcnt vmcnt(" #n ")" ::: "memory")
#define PG8_WAIT_L(n) asm volatile("s_waitcnt lgkmcnt(" #n ")" ::: "memory")
#define PG8_BAR __builtin_amdgcn_s_barrier()
#define PG8_SCHED __builtin_amdgcn_sched_barrier(0)
    Unit cur, nxt; int ui = 0;
    if (!S.next(0, cur)) return;
    f32x4 acc[2][2][4][2];
#pragma unroll
    for (int a = 0; a < 2; ++a)
#pragma unroll
        for (int b = 0; b < 2; ++b)
#pragma unroll
            for (int m = 0; m < 4; ++m)
#pragma unroll
                for (int n = 0; n < 2; ++n) acc[a][b][m][n] = (f32x4){0.f, 0.f, 0.f, 0.f};
    bf16x8 At[4][2], B0[2][2], B1[2][2];
    const char* cA = (const char*)g.A + (size_t)cur.pm * tstep + (size_t)cur.kt0 * kstep; const char* cB = (const char*)g.Bt + (size_t)cur.pn * tstep + (size_t)cur.kt0 * kstep;
    S.a_ready(cur);
    if constexpr (SP2) {
        PG8_STAGE(PG8_SB(0, 0), cB, voffB); PG8_STAGE(PG8_SB(0, 1), cB + hstep, voffB); PG8_STAGE(PG8_SA(0, 0), cA, voffA); PG8_STAGE(PG8_SA(0, 1), cA + hstep, voffA);
        if (wr == 1) PG8_BAR;
        PG8_WAIT_V(2); PG8_BAR;
        PG8_STAGE(PG8_SB(1, 0), cB + kstep, voffB); PG8_STAGE(PG8_SA(1, 0), cA + kstep, voffA); PG8_STAGE(PG8_SB(1, 1), cB + hstep + kstep, voffB);
        PG8_WAIT_V(6); PG8_BAR;
    } else {
        PG8_STAGE(PG8_SB(0, 0), cB, voffB); PG8_STAGE(PG8_SA(0, 0), cA, voffA); PG8_STAGE(PG8_SB(0, 1), cB + hstep, voffB); PG8_STAGE(PG8_SA(0, 1), cA + hstep, voffA);
        if (wr == 1) PG8_BAR;
        PG8_WAIT_V(4); PG8_BAR;
        PG8_STAGE(PG8_SB(1, 0), cB + kstep, voffB); PG8_STAGE(PG8_SA(1, 0), cA + kstep, voffA); PG8_STAGE(PG8_SB(1, 1), cB + hstep + kstep, voffB);
        PG8_WAIT_V(6); PG8_BAR;
    }
    for (;;) {
        const bool has_next = S.next(ui + 1, nxt);
        const char* nA = has_next ? (const char*)g.A + (size_t)nxt.pm * tstep + (size_t)nxt.kt0 * kstep : cA; const char* nB = has_next ? (const char*)g.Bt + (size_t)nxt.pn * tstep + (size_t)nxt.kt0 * kstep : cB;
        const int nt = cur.nt;
        for (int t = 0; t < nt; t += 2) {
            const bool last = (t == nt - 2);
            const char* a1 = cA + (size_t)(t + 1) * kstep;
            const char* a2 = last ? nA : cA + (size_t)(t + 2) * kstep; const char* b2 = last ? nB : cB + (size_t)(t + 2) * kstep;
            const char* a3 = a2 + kstep; const char* b3 = b2 + kstep;
            if (last && has_next) S.a_ready(nxt);
            if constexpr (SP2) {
            PG8_LDB(B0, 0, 0); PG8_LDB(B1, 0, 1); PG8_SCHED; PG8_LDA(At, 0, 0); PG8_STAGE(PG8_SA(1, 1), a1 + hstep, voffA);
            PG8_WAIT_V(8); PG8_WAIT_L(0); PG8_BAR; PG8_MMA(0, 0, At, B0); PG8_MMA(0, 1, At, B1); PG8_BAR; PG8_SCHED;
            PG8_LDA(At, 0, 1); PG8_STAGE(PG8_SB(0, 0), b2, voffB); PG8_STAGE(PG8_SB(0, 1), b2 + hstep, voffB); PG8_STAGE(PG8_SA(0, 0), a2, voffA);
            PG8_WAIT_V(8); PG8_WAIT_L(0); PG8_BAR; PG8_MMA(1, 0, At, B0); PG8_MMA(1, 1, At, B1); PG8_BAR; PG8_SCHED;
            PG8_LDB(B0, 1, 0); PG8_LDB(B1, 1, 1); PG8_SCHED; PG8_LDA(At, 1, 0); PG8_STAGE(PG8_SA(0, 1), a2 + hstep, voffA);
            PG8_WAIT_V(8); PG8_WAIT_L(0); PG8_BAR; PG8_MMA(0, 0, At, B0); PG8_MMA(0, 1, At, B1); PG8_BAR; PG8_SCHED;
            PG8_LDA(At, 1, 1); PG8_STAGE(PG8_SB(1, 0), b3, voffB); PG8_STAGE(PG8_SB(1, 1), b3 + hstep, voffB); PG8_STAGE(PG8_SA(1, 0), a3, voffA);
            PG8_WAIT_V(8); PG8_WAIT_L(0); PG8_BAR; PG8_MMA(1, 0, At, B0); PG8_MMA(1, 1, At, B1); PG8_BAR; PG8_SCHED;
            } else {
            PG8_LDB(B0, 0, 0); PG8_SCHED; PG8_LDA(At, 0, 0); PG8_STAGE(PG8_SA(1, 1), a1 + hstep, voffA);
            PG8_WAIT_L(8); PG8_BAR; PG8_WAIT_L(0); PG8_MMA(0, 0, At, B0); PG8_BAR; PG8_SCHED;
            PG8_LDB(B1, 0, 1); PG8_STAGE(PG8_SB(0, 0), b2, voffB);
            PG8_BAR; PG8_WAIT_L(0); PG8_MMA(0, 1, At, B1); PG8_BAR;
            PG8_LDA(At, 0, 1); PG8_STAGE(PG8_SA(0, 0), a2, voffA);
            PG8_BAR; PG8_WAIT_L(0); PG8_MMA(1, 0, At, B0); PG8_BAR; PG8_SCHED;
            PG8_STAGE(PG8_SB(0, 1), b2 + hstep, voffB);
            PG8_WAIT_V(6); PG8_BAR; PG8_MMA(1, 1, At, B1); PG8_BAR;
            PG8_LDB(B0, 1, 0); PG8_SCHED; PG8_LDA(At, 1, 0); PG8_STAGE(PG8_SA(0, 1), a2 + hstep, voffA);
            PG8_WAIT_L(8); PG8_BAR; PG8_WAIT_L(0); PG8_MMA(0, 0, At, B0); PG8_BAR; PG8_SCHED;
            PG8_LDB(B1, 1, 1); PG8_STAGE(PG8_SB(1, 0), b3, voffB);
            PG8_BAR; PG8_WAIT_L(0); PG8_MMA(0, 1, At, B1); PG8_BAR;
            PG8_LDA(At, 1, 1); PG8_STAGE(PG8_SA(1, 0), a3, voffA);
            PG8_BAR; PG8_WAIT_L(0); PG8_MMA(1, 0, At, B0); PG8_BAR; PG8_SCHED;
            PG8_STAGE(PG8_SB(1, 1), b3 + hstep, voffB);
            PG8_WAIT_V(6); PG8_BAR; PG8_MMA(1, 1, At, B1); PG8_BAR;
            }
        }
        if constexpr (ALIGN_EPI) { if (wr == 0) PG8_BAR; }
        if constexpr (!Epi::AFTER_DRAIN) { E(acc, cur, wr, wc, fr, fq); S.done(cur); }
        if (!has_next) break;
#pragma unroll
        for (int a = 0; a < 2; ++a)
#pragma unroll
            for (int b = 0; b < 2; ++b)
#pragma unroll
                for (int m = 0; m < 4; ++m)
#pragma unroll
                    for (int n = 0; n < 2; ++n) acc[a][b][m][n] = (f32x4){0.f, 0.f, 0.f, 0.f};
        cur = nxt; cA = nA; cB = nB; ++ui;
        if constexpr (ALIGN_EPI) { if (wr == 1) PG8_BAR; }
    }
    PG8_WAIT_V(0);
    if constexpr (!ALIGN_EPI) { if (wr == 0) PG8_BAR; }
    PG8_BAR;
    if constexpr (Epi::AFTER_DRAIN) { E.fused(acc, cur, wr, wc, fr, fq, lds, wid, lane); S.done(cur); }
#undef PG8_SA
#undef PG8_SB
#undef PG8_STAGE
#undef PG8_LDA
#undef PG8_LDB
#undef PG8_MMA
#undef PG8_WAIT_V
#undef PG8_WAIT_L
#undef PG8_BAR
#undef PG8_SCHED
}
}

#define LAS __attribute__((address_space(3)))
typedef unsigned short bf16_t;
typedef short bf16x8 __attribute__((ext_vector_type(8)));
typedef float f32x4 __attribute__((ext_vector_type(4)));
typedef unsigned u32x4 __attribute__((ext_vector_type(4)));
typedef unsigned u32x2 __attribute__((ext_vector_type(2)));

constexpr int DM = 1024, SEQ = 8192, NB = 2, DEPTH = 4, DB = 32, DS = 4;
constexpr int MP = NB * SEQ;
constexpr int MS = DB * DS;
constexpr int MR = MP + MS;
constexpr int MPAD = 16640;
constexpr int FF = 2816, NIN = 3328, ZW = 3072;
constexpr int ZQ = 256, ZK = 512, ZV = 768, ZHQ = 1024, ZHK = 1536, ZHV = 2048, ZHG = 2560;
constexpr float EPS = 1e-6f;
constexpr int NTHR = 512;
constexpr int LDS_BYTES = 151552;

constexpr size_t al256(size_t x) { return (x + 255) & ~(size_t)255; }
constexpr size_t SZ_WGU = (size_t)2 * FF * DM * 2, SZ_WD = (size_t)DM * FF * 2, SZ_WIN = (size_t)NIN * DM * 2, SZ_WO = (size_t)DM * DM * 2;
constexpr size_t WS_WGU = 0;
constexpr size_t WS_WD = WS_WGU + 8 * SZ_WGU;
constexpr size_t WS_WIN = WS_WD + 8 * SZ_WD;
constexpr size_t WS_WO = WS_WIN + 4 * SZ_WIN;
constexpr size_t WS_LB = WS_WO + 4 * SZ_WO;
constexpr size_t WS_X = al256(WS_LB + 4 * 512 * 4);
constexpr size_t WS_XN = WS_X + (size_t)MPAD * DM * 4;
constexpr size_t WS_ACT = WS_XN + (size_t)MPAD * DM * 2;
constexpr size_t WS_ZB = WS_ACT + (size_t)MPAD * FF * 2;
constexpr size_t WS_LF = WS_ZB + (size_t)MPAD * ZW * 2;
constexpr size_t WS_Y = WS_LF + (size_t)MPAD * 512 * 4;
constexpr size_t WS_OP = WS_Y + (size_t)MPAD * DM * 2;
constexpr size_t WS_LSE = WS_OP + (size_t)3 * MP * 256 * 4;
constexpr size_t WS_SL = WS_LSE + (size_t)3 * MP * 4 * 4;
constexpr size_t WS_SP = WS_SL + (size_t)1024 * 16384 * 4;
constexpr size_t WS_DC = WS_SP + (size_t)1024 * 16384 * 2;
constexpr size_t WS_BAR = WS_DC + (size_t)1024 * 128 * 4;
constexpr size_t WS_BAR_BYTES = 16384;
constexpr size_t WS_END = WS_BAR + WS_BAR_BYTES;

constexpr size_t O_YP = 0, O_YS = 16777216, O_CP = O_YS + 131072, O_CS = O_CP + 61440, O_KP = O_CS + 983040, O_VP = O_KP + 4194304,
                 O_KS = O_VP + 4194304, O_VS = O_KS + 131072, O_HP = O_VS + 131072, O_HS = O_HP + 524288, O_END = O_HS + 8388608;

struct Args {
    const float* in[24];
    float* out;
    unsigned char* ws;
};

struct Ctx { int tid, wave, G, bid; };
extern __shared__ __attribute__((aligned(16))) unsigned char lds_raw[];
constexpr int PT_OFF = 150528;
__device__ __forceinline__ unsigned long long ptab_ld(int k) {
    const unsigned long long v = ((const LAS unsigned long long*)((LAS unsigned char*)lds_raw + PT_OFF))[k];
    const unsigned lo = __builtin_amdgcn_readfirstlane((unsigned)v), hi = __builtin_amdgcn_readfirstlane((unsigned)(v >> 32));
    return ((unsigned long long)hi << 32) | lo;
}
#define GAS1 __attribute__((address_space(1)))
#define PIN(k) ((const float*)(const GAS1 float*)ptab_ld(k))
#define POUT ((float*)(GAS1 float*)ptab_ld(24))
#define PWS ((unsigned char*)(GAS1 unsigned char*)ptab_ld(25))
#define WSP(T, off) ((T*)(PWS + (off)))

__device__ __forceinline__ unsigned f2bf(float f) { unsigned u = __builtin_bit_cast(unsigned, f); return (u + 0x7fffu + ((u >> 16) & 1u)) >> 16; }
__device__ __forceinline__ unsigned pk2(float lo, float hi) { return f2bf(lo) | (f2bf(hi) << 16); }
__device__ __forceinline__ float bf2f(unsigned h) { return __builtin_bit_cast(float, (h & 0xffffu) << 16); }
__device__ __forceinline__ float bflo(unsigned w) { return __builtin_bit_cast(float, w << 16); }
__device__ __forceinline__ float bfhi(unsigned w) { return __builtin_bit_cast(float, w & 0xffff0000u); }
__device__ __forceinline__ float sigmoidf_(float x) { return __builtin_amdgcn_rcpf(1.f + __expf(-x)); }
__device__ __forceinline__ float siluf_(float x) { return x * sigmoidf_(x); }
__device__ __forceinline__ float wave_sum(float v) {
#pragma unroll
    for (int o = 1; o < 64; o <<= 1) v += __shfl_xor(v, o);
    return v;
}
__device__ __forceinline__ float wave_max(float v) {
#pragma unroll
    for (int o = 1; o < 64; o <<= 1) v = fmaxf(v, __shfl_xor(v, o));
    return v;
}
__device__ __forceinline__ float sum16(float v) { v += __shfl_xor(v, 1); v += __shfl_xor(v, 2); v += __shfl_xor(v, 4); v += __shfl_xor(v, 8); return v; }
__device__ __forceinline__ float max16(float v) { v = fmaxf(v, __shfl_xor(v, 1)); v = fmaxf(v, __shfl_xor(v, 2)); v = fmaxf(v, __shfl_xor(v, 4)); v = fmaxf(v, __shfl_xor(v, 8)); return v; }
__device__ __forceinline__ bf16x8 ldfrag(const LAS bf16_t* base, int ld, int r0, int k0, int lane) {
    return *(const LAS bf16x8*)(base + (r0 + (lane & 15)) * ld + k0 + 8 * (lane >> 4));
}
#define MFMA16(a, b, c) __builtin_amdgcn_mfma_f32_16x16x32_bf16((a), (b), (c), 0, 0, 0)
#define LDS_FENCE() asm volatile("s_waitcnt lgkmcnt(0)" ::: "memory")

struct EpiSwiglu {
    static constexpr bool PERM = true, AFTER_DRAIN = false;
    bf16_t* O;
    __device__ __forceinline__ void operator()(const f32x4 (&acc)[2][2][4][2], const pg8::Unit& u_, int wr, int wc_, int fr_, int fq_) const {
        pg8::Unit u = u_; int wc = wc_, fr = fr_, fq = fq_; asm volatile("" : "+s"(u.pm), "+s"(u.pn), "+v"(fr), "+v"(fq), "+s"(wc));
        const int row0 = u.pm * 256 + wr * 64 + fr, col0 = u.pn * 128 + wc * 32 + 8 * fq;
#pragma unroll
        for (int ai = 0; ai < 2; ++ai)
#pragma unroll
            for (int m = 0; m < 4; ++m) {
                bf16_t* rowp = O + (size_t)(row0 + ai * 128 + m * 16) * FF + col0;
                float v[8];
#pragma unroll
                for (int n = 0; n < 2; ++n)
#pragma unroll
                    for (int i = 0; i < 4; ++i) v[n * 4 + i] = siluf_(acc[ai][0][m][n][i]) * acc[ai][1][m][n][i];
                u32x4 w; w.x = pk2(v[0], v[1]); w.y = pk2(v[2], v[3]); w.z = pk2(v[4], v[5]); w.w = pk2(v[6], v[7]);
                *(u32x4*)rowp = w;
            }
    }
};
struct EpiResid {
    static constexpr bool PERM = false, AFTER_DRAIN = false;
    float* X; float* P;
    __device__ __forceinline__ void operator()(const f32x4 (&acc)[2][2][4][2], const pg8::Unit& u_, int wr, int wc_, int fr_, int fq_) const {
        pg8::Unit u = u_; int wc = wc_, fr = fr_, fq = fq_; asm volatile("" : "+s"(u.pm), "+s"(u.pn), "+v"(fr), "+v"(fq), "+s"(wc));
        const int row0 = u.pm * 256 + wr * 64 + fr, col0 = u.pn * 256 + wc * 32 + 4 * fq;
        if (u.pm == MP / 256) {
            float* Pb = P + (size_t)(u.kt0 / u.nt) * 128 * DM;
#pragma unroll
            for (int m = 0; m < 4; ++m) {
                float* p = Pb + (size_t)(wr * 64 + m * 16 + fr) * DM + col0;
#pragma unroll
                for (int bj = 0; bj < 2; ++bj)
#pragma unroll
                    for (int n = 0; n < 2; ++n) *(f32x4*)(p + bj * 128 + n * 16) = acc[0][bj][m][n];
            }
            return;
        }
#pragma unroll
        for (int ai = 0; ai < 2; ++ai)
#pragma unroll
            for (int m = 0; m < 4; ++m) {
                float* p = X + (size_t)(row0 + ai * 128 + m * 16) * DM + col0;
                f32x4 t[2][2];
#pragma unroll
                for (int bj = 0; bj < 2; ++bj)
#pragma unroll
                    for (int n = 0; n < 2; ++n) t[bj][n] = *(const f32x4*)(p + bj * 128 + n * 16);
#pragma unroll
                for (int bj = 0; bj < 2; ++bj)
#pragma unroll
                    for (int n = 0; n < 2; ++n) *(f32x4*)(p + bj * 128 + n * 16) = t[bj][n] + acc[ai][bj][m][n];
                if (m == 3) asm volatile("" ::: "memory");
            }
    }
};
struct EpiWin {
    static constexpr bool PERM = true, AFTER_DRAIN = false;
    bf16_t* ZB; float* LF; const float* LB  ; float* outK; float* outV; float* outKs; float* outVs;
    __device__ __forceinline__ void operator()(const f32x4 (&acc)[2][2][4][2], const pg8::Unit& u_, int wr, int wc_, int fr_, int fq_) const {
        pg8::Unit u = u_; int wc = wc_, fr = fr_, fq = fq_; asm volatile("" : "+s"(u.pm), "+s"(u.pn), "+v"(fr), "+v"(fq), "+s"(wc));
        const int row0 = u.pm * 256 + wr * 64 + fr; const int pn = u.pn; const int cw = wc * 32 + 8 * fq;
        if (pn < 2) {
#pragma unroll
            for (int ai = 0; ai < 2; ++ai)
#pragma unroll
                for (int m = 0; m < 4; ++m) {
                    const int row = row0 + ai * 128 + m * 16; float v[8];
#pragma unroll
                    for (int n = 0; n < 2; ++n)
#pragma unroll
                        for (int i = 0; i < 4; ++i) v[n * 4 + i] = acc[ai][0][m][n][i] * sigmoidf_(acc[ai][1][m][n][i]);
                    u32x4 w; w.x = pk2(v[0], v[1]); w.y = pk2(v[2], v[3]); w.z = pk2(v[4], v[5]); w.w = pk2(v[6], v[7]);
                    *(u32x4*)(ZB + (size_t)row * ZW + pn * 128 + cw) = w;
                }
            return;
        }
        int zcol; int kind;
        if (pn == 2) { zcol = ZQ; kind = 0; } else if (pn == 3) { zcol = ZK; kind = 1; } else if (pn == 4) { zcol = ZV; kind = 2; }
        else if (pn < 7) { zcol = ZHQ + (pn - 5) * 256; kind = 3; } else if (pn < 9) { zcol = ZHK + (pn - 7) * 256; kind = 4; }
        else if (pn < 11) { zcol = ZHV + (pn - 9) * 256; kind = 5; } else { zcol = ZHG + (pn - 11) * 256; kind = 3; }
#pragma unroll
        for (int bj = 0; bj < 2; ++bj) {
            const int cin = bj * 128 + cw;
            float lb[8];
            if (kind == 4) {
#pragma unroll
                for (int i = 0; i < 8; ++i) lb[i] = LB[(pn - 7) * 256 + cin + i];
            }
#pragma unroll
            for (int ai = 0; ai < 2; ++ai)
#pragma unroll
                for (int m = 0; m < 4; ++m) {
                    const int row = row0 + ai * 128 + m * 16; float v[8];
#pragma unroll
                    for (int n = 0; n < 2; ++n)
#pragma unroll
                        for (int i = 0; i < 4; ++i) v[n * 4 + i] = acc[ai][bj][m][n][i];
                    if (kind == 1 || kind == 2) {
                        float* dst = nullptr;
                        if (row < MP) { const int b = row >> 13, t = row & (SEQ - 1); if (t >= SEQ - 2048) dst = (kind == 1 ? outK : outV) + ((size_t)(b * 2048 + (t - (SEQ - 2048))) * 256 + cin); }
                        else if (row < MR) dst = (kind == 1 ? outKs : outVs) + ((size_t)(row - MP) * 256 + cin);
                        if (dst) { *(f32x4*)dst = (f32x4){v[0], v[1], v[2], v[3]}; *(f32x4*)(dst + 4) = (f32x4){v[4], v[5], v[6], v[7]}; }
                    }
                    if (kind == 0) {
#pragma unroll
                        for (int i = 0; i < 8; ++i) v[i] *= 0.125f;
                    } else if (kind == 3) {
#pragma unroll
                        for (int i = 0; i < 8; ++i) v[i] = siluf_(v[i]);
                    } else if (kind == 4) {
                        float lf[8];
#pragma unroll
                        for (int i = 0; i < 8; ++i) { const float sg = sigmoidf_(v[i]); const float f = lb[i] + (1.f - lb[i]) * sg; lf[i] = __logf(f); v[i] = (1.f - lb[i]) * sigmoidf_(-v[i]); }
                        float* lp = LF + (size_t)row * 512 + (pn - 7) * 256 + cin;
                        *(f32x4*)lp = (f32x4){lf[0], lf[1], lf[2], lf[3]}; *(f32x4*)(lp + 4) = (f32x4){lf[4], lf[5], lf[6], lf[7]};
                    }
                    u32x4 w; w.x = pk2(v[0], v[1]); w.y = pk2(v[2], v[3]); w.z = pk2(v[4], v[5]); w.w = pk2(v[6], v[7]);
                    *(u32x4*)(ZB + (size_t)row * ZW + zcol + cin) = w;
                }
        }
    }
};

__device__ __forceinline__ void transpose_item(const float* W, int K, int N, int k0, int n0, bf16_t* dst, LAS float* scr, int lane, float wscale = 1.0f) {
#pragma unroll 8
    for (int i = 0; i < 32; ++i) { const int kk = 2 * i + (lane >> 5); scr[kk * 33 + (lane & 31)] = wscale * W[(size_t)(k0 + kk) * N + n0 + (lane & 31)]; }
    LDS_FENCE();
    const int c = lane & 7;
#pragma unroll
    for (int j = 0; j < 4; ++j) { const int n = (lane >> 3) + 8 * j; const LAS float* s = scr + (8 * c) * 33 + n;
        u32x4 o; o.x = pk2(s[0 * 33], s[1 * 33]); o.y = pk2(s[2 * 33], s[3 * 33]); o.z = pk2(s[4 * 33], s[5 * 33]); o.w = pk2(s[6 * 33], s[7 * 33]);
        *(u32x4*)(dst + (size_t)n * K + k0 + 8 * c) = o; }
    LDS_FENCE();
}
constexpr int IT_GU = 16 * 88, IT_D = 44 * 32, IT_FFN = 2 * IT_GU + IT_D, IT_WIN = 16 * 104, IT_WO = 16 * 32, IT_LAYER = 2 * IT_FFN + IT_WIN + IT_WO;
__device__ __forceinline__ void weight_item(const Args& A, const Ctx& C, int it, LAS float* scr) {
    const int l = it / IT_LAYER; int r = it % IT_LAYER;
    if (r < 2 * IT_FFN) {
        const int f = r / IT_FFN; const int q = r % IT_FFN;
        if (q < 2 * IT_GU) {
            const int which = q / IT_GU, idx = q % IT_GU, kb = idx / 88, nb = idx % 88, n0 = nb * 32;
            const float* W = (f == 0 ? (which == 0 ? PIN(7) : PIN(8)) : (which == 0 ? PIN(20) : PIN(21))) + (size_t)l * DM * FF;
            const int drow = (n0 >> 7) * 256 + (n0 & 127) + which * 128;
            bf16_t* dst = (bf16_t*)(PWS + WS_WGU + (size_t)(l * 2 + f) * SZ_WGU) + (size_t)drow * DM;
            transpose_item(W, DM, FF, kb * 64, n0, dst, scr, (C.tid & 63));
        } else {
            const int idx = q - 2 * IT_GU, kb = idx / 32, nb = idx % 32, n0 = nb * 32;
            const float* W = (f == 0 ? PIN(9) : PIN(22)) + (size_t)l * FF * DM;
            bf16_t* dst = (bf16_t*)(PWS + WS_WD + (size_t)(l * 2 + f) * SZ_WD) + (size_t)n0 * FF;
            transpose_item(W, FF, DM, kb * 64, n0, dst, scr, (C.tid & 63), 0.5f);
        }
        return;
    }
    r -= 2 * IT_FFN;
    if (r < IT_WIN) {
        const int kb = r / 104, nb = r % 104, n0 = nb * 32;
        const float* W = PIN(11) + (size_t)l * DM * NIN;
        int drow = n0;
        if (n0 < 256) drow = (n0 >> 7) * 256 + (n0 & 127);
        else if (n0 < 512) { const int j = n0 - 256; drow = (j >> 7) * 256 + 128 + (j & 127); }
        bf16_t* dst = (bf16_t*)(PWS + WS_WIN + (size_t)l * SZ_WIN) + (size_t)drow * DM;
        transpose_item(W, DM, NIN, kb * 64, n0, dst, scr, (C.tid & 63));
        return;
    }
    r -= IT_WIN;
    {
        const int kb = r / 32, nb = r % 32, n0 = nb * 32;
        const float* W = PIN(18) + (size_t)l * DM * DM;
        bf16_t* dst = (bf16_t*)(PWS + WS_WO + (size_t)l * SZ_WO) + (size_t)n0 * DM;
        transpose_item(W, DM, DM, kb * 64, n0, dst, scr, (C.tid & 63));
    }
}

template <int MODE>
__device__ __forceinline__ void norm_phase(const Args& A, const Ctx& C, const float* g, int nsplit = 0) {
    int tl_ = C.tid; asm volatile("" : "+v"(tl_)); const int lane_ = tl_ & 63;
    const int gw = C.bid * 8 + C.wave, NGW = C.G * 8;
    f32x4 gv[4];
#pragma unroll
    for (int j = 0; j < 4; ++j) gv[j] = ((const f32x4*)g)[lane_ + 64 * j];
    f32x4 vn[4] = {};
    if (gw < MR) { const int m = gw;
        const float* src = (MODE == 1) ? (m < MP ? PIN(0) + (size_t)m * DM : PIN(1) + (size_t)(m - MP) * DM) : WSP(float, WS_X) + (size_t)m * DM;
#pragma unroll
        for (int j = 0; j < 4; ++j) vn[j] = ((const f32x4*)src + lane_)[64 * j]; }
    for (int m = gw; m < MR; m += NGW) {
        f32x4 v[4]; float s = 0.f;
#pragma unroll
        for (int j = 0; j < 4; ++j) v[j] = vn[j];
        { const int mn = m + NGW;
          if (mn < MR) { const float* srcn = (MODE == 1) ? (mn < MP ? PIN(0) + (size_t)mn * DM : PIN(1) + (size_t)(mn - MP) * DM) : WSP(float, WS_X) + (size_t)mn * DM;
#pragma unroll
            for (int j = 0; j < 4; ++j) vn[j] = ((const f32x4*)srcn + lane_)[64 * j]; } }
#pragma unroll
        for (int j = 0; j < 4; ++j) s += (v[j].x * v[j].x + v[j].y * v[j].y) + (v[j].z * v[j].z + v[j].w * v[j].w);
        if (MODE != 1 && m >= MP) {
            const float* Pr = WSP(float, WS_SL) + (size_t)(m - MP) * DM;
#pragma unroll
            for (int j = 0; j < 4; ++j) {
                f32x4 pv[11];
#pragma unroll
                for (int p = 0; p < 11; ++p) pv[p] = (p < nsplit) ? ((const f32x4*)(Pr + (size_t)p * 128 * DM))[lane_ + 64 * j] : (f32x4){0.f, 0.f, 0.f, 0.f};
#pragma unroll
                for (int p = 0; p < 11; ++p) v[j] = v[j] + pv[p];
            }
            f32x4* xo = (f32x4*)(WSP(float, WS_X) + (size_t)m * DM) + lane_; s = 0.f;
#pragma unroll
            for (int j = 0; j < 4; ++j) { xo[64 * j] = v[j]; s += (v[j].x * v[j].x + v[j].y * v[j].y) + (v[j].z * v[j].z + v[j].w * v[j].w); }
        }
        const float rstd = 1.0f / sqrtf(wave_sum(s) * (1.f / DM) + EPS);
        if (MODE == 1) {
            f32x4* xo = (f32x4*)(WSP(float, WS_X) + (size_t)m * DM) + lane_;
#pragma unroll
            for (int j = 0; j < 4; ++j) xo[64 * j] = v[j];
        }
        if (MODE == 2) {
            f32x4* yo = (f32x4*)(POUT + (size_t)m * DM) + lane_;
#pragma unroll
            for (int j = 0; j < 4; ++j) yo[64 * j] = v[j] * rstd * gv[j];
        } else {
            u32x2* o8 = (u32x2*)(WSP(bf16_t, WS_XN) + (size_t)m * DM) + lane_;
#pragma unroll
            for (int j = 0; j < 4; ++j) { const f32x4 y = v[j] * rstd * gv[j]; u32x2 w; w.x = pk2(y.x, y.y); w.y = pk2(y.z, y.w); o8[64 * j] = w; }
        }
    }
}

__device__ __forceinline__ void prologue_phase(const Args& A, const Ctx& C, LAS unsigned char* lds) {
    LAS float* scr = (LAS float*)(lds + C.wave * 16384);
    const int gw = C.bid * 8 + C.wave, NGW = C.G * 8;
    for (int it = gw; it < DEPTH * IT_LAYER; it += NGW) weight_item(A, C, it, scr);
    const int gt = C.bid * NTHR + C.tid, NGT = C.G * NTHR;
    for (int c = gt; c < 512; c += NGT) {
        float v[4], mx = -1e30f;
#pragma unroll
        for (int l = 0; l < 4; ++l) { v[l] = PIN(16)[l * 512 + c]; mx = fmaxf(mx, v[l]); }
        float s = 0.f;
#pragma unroll
        for (int l = 0; l < 4; ++l) { v[l] = __expf(v[l] - mx); s += v[l]; }
        const float inv = 1.f / s; float cum = 0.f;
        WSP(float, WS_LB)[c] = 0.f;
#pragma unroll
        for (int l = 1; l < 4; ++l) { cum += v[l] * inv; WSP(float, WS_LB)[l * 512 + c] = cum; }
    }
    for (int i = gt; i < (MPAD - MR) * DM; i += NGT) { WSP(float, WS_X)[(size_t)MR * DM + i] = 0.f; WSP(bf16_t, WS_XN)[(size_t)MR * DM + i] = 0; WSP(bf16_t, WS_Y)[(size_t)MR * DM + i] = 0; }
    norm_phase<1>(A, C, PIN(6));
}

struct AttnRegs { u32x4 q[2], k[4], v[4]; };
__device__ __forceinline__ void attn_load(const Args& A, int item, int tid, AttnRegs& R) {
    const int br = item >> 9, rem = item & 511, b = rem >> 8, h = (rem >> 6) & 3, n = rem & 63;
    const int sh = 2 * br, nbc = 64 >> sh, r = n / nbc, cb = n % nbc;
    const bf16_t* Zb = WSP(bf16_t, WS_ZB) + (size_t)(b * SEQ) * ZW;
#pragma unroll
    for (int a = 0; a < 2; ++a) { const int i = tid + a * NTHR; const int qi = i >> 3, ch = i & 7; const int t = ((cb * 128 + qi) << sh) + r;
        R.q[a] = *(const u32x4*)(Zb + (size_t)t * ZW + ZQ + h * 64 + ch * 8); }
#pragma unroll
    for (int a = 0; a < 4; ++a) { const int i = tid + a * NTHR; const int ki = i >> 3, ch = i & 7; const int u = (cb - 1) * 128 + ki;
        const int t = ((u < 0 ? 0 : u) << sh) + r; const bf16_t* p = Zb + (size_t)t * ZW + h * 64 + ch * 8;
        R.k[a] = *(const u32x4*)(p + ZK); R.v[a] = *(const u32x4*)(p + ZV);
        if (u < 0) { R.k[a] = (u32x4){0u, 0u, 0u, 0u}; R.v[a] = (u32x4){0u, 0u, 0u, 0u}; } }
}
__device__ __forceinline__ void attn_item(const Args& A, const Ctx& C, int item, int next_item, AttnRegs& R, LAS unsigned char* lds) {
    const int br = item >> 9, rem = item & 511, b = rem >> 8, h = (rem >> 6) & 3, n = rem & 63;
    const int sh = 2 * br, nbc = 64 >> sh, r = n / nbc, cb = n % nbc;
    LAS bf16_t* Qs = (LAS bf16_t*)lds;
    LAS bf16_t* Ks = Qs + 128 * 72;
    LAS bf16_t* VT = Ks + 256 * 72;
    LAS bf16_t* Ps = VT + 64 * 280;
    const bf16_t* Zb = WSP(bf16_t, WS_ZB) + (size_t)(b * SEQ) * ZW;
    int tid = C.tid, w = C.wave; asm volatile("" : "+v"(tid), "+s"(w)); const int lane = tid & 63, fr = lane & 15, fq = lane >> 4;
    __syncthreads();
    {
#pragma unroll
        for (int a = 0; a < 2; ++a) { const int i = tid + a * NTHR; const int qi = i >> 3, ch = i & 7; *(LAS u32x4*)(Qs + qi * 72 + ch * 8) = R.q[a]; }
#pragma unroll
        for (int a = 0; a < 4; ++a) { const int i = tid + a * NTHR; const int ki = i >> 3, ch = i & 7;
            *(LAS u32x4*)(Ks + ki * 72 + ch * 8) = R.k[a];
            LAS bf16_t* vt = VT + (ch * 8) * 280 + ki; const u32x4 w4 = R.v[a];
            vt[0 * 280] = (bf16_t)(w4.x & 0xffffu); vt[1 * 280] = (bf16_t)(w4.x >> 16); vt[2 * 280] = (bf16_t)(w4.y & 0xffffu); vt[3 * 280] = (bf16_t)(w4.y >> 16);
            vt[4 * 280] = (bf16_t)(w4.z & 0xffffu); vt[5 * 280] = (bf16_t)(w4.z >> 16); vt[6 * 280] = (bf16_t)(w4.w & 0xffffu); vt[7 * 280] = (bf16_t)(w4.w >> 16); }
    }
    for (int i = tid; i < 1024; i += NTHR) VT[(i >> 4) * 280 + 256 + (i & 15)] = 0;
    __syncthreads();
    if (next_item >= 0) attn_load(A, next_item, tid, R);
    f32x4 s[9];
    {
        bf16x8 aq[2];
#pragma unroll
        for (int k = 0; k < 2; ++k) aq[k] = ldfrag(Qs, 72, 16 * w, 32 * k, lane);
#pragma unroll
        for (int j = 0; j < 9; ++j) { s[j] = (f32x4){0.f, 0.f, 0.f, 0.f};
#pragma unroll
            for (int k = 0; k < 2; ++k) { const bf16x8 bk = ldfrag(Ks, 72, 16 * (w + j), 32 * k, lane); s[j] = MFMA16(aq[k], bk, s[j]); } }
    }
    const float slope = exp2f(-2.f * (float)(h + 1));
    float mx[4] = {-1e30f, -1e30f, -1e30f, -1e30f};
#pragma unroll
    for (int j = 0; j < 9; ++j)
#pragma unroll
        for (int i = 0; i < 4; ++i) {
            const int qi = 16 * w + 4 * fq + i, ki = 16 * (w + j) + fr, jd = qi - ki + 128;
            const bool valid = (jd >= 0) && (jd <= 128) && (cb > 0 || ki >= 128);
            const float val = s[j][i] - slope * (float)(jd << sh);
            s[j][i] = valid ? val : -1e30f; mx[i] = fmaxf(mx[i], s[j][i]);
        }
    float ls[4];
#pragma unroll
    for (int i = 0; i < 4; ++i) { mx[i] = max16(mx[i]); ls[i] = 0.f; }
    LAS bf16_t* Pw = Ps + w * 16 * 168;
#pragma unroll
    for (int j = 0; j < 9; ++j)
#pragma unroll
        for (int i = 0; i < 4; ++i) { const float p = __expf(s[j][i] - mx[i]); ls[i] += p; Pw[(4 * fq + i) * 168 + j * 16 + fr] = (bf16_t)f2bf(p); }
#pragma unroll
    for (int e = 0; e < 4; ++e) { const int idx = lane * 4 + e; Pw[(idx >> 4) * 168 + 144 + (idx & 15)] = 0; }
#pragma unroll
    for (int i = 0; i < 4; ++i) ls[i] = sum16(ls[i]);
    LDS_FENCE();
    f32x4 o[4];
#pragma unroll
    for (int d = 0; d < 4; ++d) o[d] = (f32x4){0.f, 0.f, 0.f, 0.f};
#pragma unroll
    for (int ks = 0; ks < 5; ++ks) { const bf16x8 ap = ldfrag(Pw, 168, 0, 32 * ks, lane);
#pragma unroll
        for (int d = 0; d < 4; ++d) { const bf16x8 bv = ldfrag(VT, 280, 16 * d, 16 * w + 32 * ks, lane); o[d] = MFMA16(ap, bv, o[d]); } }
    float* OPb = WSP(float, WS_OP) + (size_t)br * MP * 256; float* LSb = WSP(float, WS_LSE) + (size_t)br * MP * 4;
#pragma unroll
    for (int i = 0; i < 4; ++i) {
        const int qi = 16 * w + 4 * fq + i; const int t = ((cb * 128 + qi) << sh) + r; const size_t grow = (size_t)b * SEQ + t;
        const float inv = 1.f / ls[i];
#pragma unroll
        for (int d = 0; d < 4; ++d) OPb[grow * 256 + h * 64 + 16 * d + fr] = o[d][i] * inv;
        if (fr == 0) LSb[grow * 4 + h] = mx[i] + __logf(ls[i]);
    }
}

__device__ __forceinline__ void chunk_cumsum(const float* src, LAS float* Bc, LAS float* Tot, int tid) {
    const int d = tid & 127, part = tid >> 7;
    float run = 0.f;
#pragma unroll
    for (int s = 0; s < 16; ++s) { run += src[(size_t)(part * 16 + s) * 512 + d]; Bc[(part * 16 + s) * 128 + d] = run; }
    Tot[part * 128 + d] = run;
    __syncthreads();
    float off = 0.f;
#pragma unroll
    for (int p = 0; p < 3; ++p) if (p < part) off += Tot[p * 128 + d];
#pragma unroll
    for (int s = 0; s < 16; ++s) Bc[(part * 16 + s) * 128 + d] += off;
    __syncthreads();
}
constexpr int H_BC = 0, H_TOT = 32768, H_A = 34816;
__device__ __forceinline__ void chunk_cumsum_regs(const float (&lf)[16], LAS float* Bc, LAS float* Tot, int tid) {
    const int d = tid & 127, part = tid >> 7;
    float run = 0.f;
#pragma unroll
    for (int s = 0; s < 16; ++s) { run += lf[s]; Bc[(part * 16 + s) * 128 + d] = run; }
    Tot[part * 128 + d] = run;
    __syncthreads();
    float off = 0.f;
#pragma unroll
    for (int p = 0; p < 3; ++p) if (p < part) off += Tot[p * 128 + d];
#pragma unroll
    for (int s = 0; s < 16; ++s) Bc[(part * 16 + s) * 128 + d] += off;
    __syncthreads();
}
struct H1Regs { u32x4 k[2], v[2]; float lf[16]; };
__device__ __forceinline__ void h1_load(const Args& A, int item, int tid, H1Regs& R) {
    const int bh = item >> 7, c = item & 127, b = bh >> 2, h = bh & 3; const size_t row0 = (size_t)b * SEQ + c * 64;
#pragma unroll
    for (int a = 0; a < 2; ++a) { const int i = tid + a * NTHR; const int s = i >> 4, ch = i & 15, d0 = ch * 8;
        const bf16_t* p = WSP(bf16_t, WS_ZB) + (row0 + s) * ZW + h * 128 + d0; R.k[a] = *(const u32x4*)(p + ZHK); R.v[a] = *(const u32x4*)(p + ZHV); }
    { const float* src = WSP(float, WS_LF) + row0 * 512 + h * 128; const int d = tid & 127, part = tid >> 7;
#pragma unroll
      for (int s = 0; s < 16; ++s) R.lf[s] = src[(size_t)(part * 16 + s) * 512 + d]; }
}
__device__ __forceinline__ void h1_item(const Args& A, const Ctx& C, int item, int next_item, H1Regs& R, LAS unsigned char* lds) {
    const int bh = item >> 7, c = item & 127, b = bh >> 2, h = bh & 3; const size_t row0 = (size_t)b * SEQ + c * 64;
    LAS float* Bc = (LAS float*)(lds + H_BC); LAS float* Tot = (LAS float*)(lds + H_TOT);
    LAS bf16_t* KT = (LAS bf16_t*)(lds + H_A);
    LAS bf16_t* VT = KT + 128 * 72;
    int tid = C.tid, w = C.wave; asm volatile("" : "+v"(tid), "+s"(w)); const int lane = tid & 63, fr = lane & 15, fq = lane >> 4;
    __syncthreads();
    chunk_cumsum_regs(R.lf, Bc, Tot, tid);
#pragma unroll
    for (int a = 0; a < 2; ++a) { const int i = tid + a * NTHR; const int s = i >> 4, ch = i & 15, d0 = ch * 8;
        const u32x4 kk = R.k[a], vv = R.v[a];
        const unsigned kw[4] = {kk.x, kk.y, kk.z, kk.w}, vw[4] = {vv.x, vv.y, vv.z, vv.w};
#pragma unroll
        for (int e = 0; e < 8; ++e) { const int d = d0 + e; const float kf = (e & 1) ? bfhi(kw[e >> 1]) : bflo(kw[e >> 1]);
            const float kt = kf * __expf(Bc[63 * 128 + d] - Bc[s * 128 + d]);
            KT[d * 72 + s] = (bf16_t)f2bf(kt);
            VT[d * 72 + s] = (bf16_t)((e & 1) ? (vw[e >> 1] >> 16) : (vw[e >> 1] & 0xffffu)); } }
    __syncthreads();
    if (next_item >= 0) h1_load(A, next_item, tid, R);
    f32x4 acc[8];
#pragma unroll
    for (int j = 0; j < 8; ++j) acc[j] = (f32x4){0.f, 0.f, 0.f, 0.f};
#pragma unroll
    for (int k = 0; k < 2; ++k) { const bf16x8 av = ldfrag(VT, 72, 16 * w, 32 * k, lane);
#pragma unroll
        for (int j = 0; j < 8; ++j) { const bf16x8 bk = ldfrag(KT, 72, 16 * j, 32 * k, lane); acc[j] = MFMA16(av, bk, acc[j]); } }
    float* SLi = WSP(float, WS_SL) + (size_t)item * 16384;
#pragma unroll
    for (int j = 0; j < 8; ++j)
#pragma unroll
        for (int i = 0; i < 4; ++i) SLi[(16 * w + 4 * fq + i) * 128 + 16 * j + fr] = acc[j][i];
    if (tid < 128) WSP(float, WS_DC)[(size_t)item * 128 + tid] = __expf(Bc[63 * 128 + tid]);
}

__device__ __forceinline__ void conv_item(const Args& A, const Ctx& C, int l, int item, LAS unsigned char* lds) {
    const int b = item >> 7, tt = item & 127, t0 = tt * 64;
    LAS bf16_t* Us = (LAS bf16_t*)lds;
    LAS float* Ys = (LAS float*)(lds + 48128);
    int tid = C.tid, w = C.wave; asm volatile("" : "+v"(tid), "+s"(w)); const int lane = tid & 63;
    __syncthreads();
    for (int i = tid; i < 94 * 32; i += NTHR) { const int rr = i >> 5, ch = i & 31; const int t = t0 - 30 + rr;
        u32x4 v = (u32x4){0u, 0u, 0u, 0u};
        if (t >= 0) v = *(const u32x4*)(WSP(bf16_t, WS_ZB) + ((size_t)b * SEQ + t) * ZW + ch * 8);
        *(LAS u32x4*)(Us + rr * 256 + ch * 8) = v; }
    __syncthreads();
    {
        const int c = tid & 255, half = tid >> 8;
        const float* Wl = PIN(12) + (size_t)l * 31 * 256;
        float wv[31];
#pragma unroll
        for (int k = 0; k < 31; ++k) wv[k] = Wl[k * 256 + c];
        const float bias = PIN(13)[l * 256 + c];
        float acc[32];
#pragma unroll
        for (int k = 0; k < 32; ++k) acc[k] = bias;
#pragma unroll
        for (int i = 0; i < 62; ++i) {
            const float x = bf2f(Us[(half * 32 + i) * 256 + c]);
#pragma unroll
            for (int k = 0; k < 32; ++k) { if (i - k >= 0 && i - k <= 30) acc[k] += wv[i - k] * x; }
        }
#pragma unroll
        for (int k = 0; k < 32; ++k) Ys[(half * 32 + k) * 257 + c] = acc[k];
    }
    __syncthreads();
    {
        const float* gl = PIN(14) + l * 256; const float* bl = PIN(15) + l * 256;
        float gg[4], bb[4];
#pragma unroll
        for (int j = 0; j < 4; ++j) { gg[j] = gl[lane + 64 * j]; bb[j] = bl[lane + 64 * j]; }
        for (int k = 0; k < 8; ++k) {
            const int tl = w * 8 + k; float v[4]; float s = 0.f;
#pragma unroll
            for (int j = 0; j < 4; ++j) { v[j] = Ys[tl * 257 + lane + 64 * j]; s += v[j]; }
            const float mean = wave_sum(s) * (1.f / 256.f); float q = 0.f;
#pragma unroll
            for (int j = 0; j < 4; ++j) { v[j] -= mean; q += v[j] * v[j]; }
            const float rstd = 1.0f / sqrtf(wave_sum(q) * (1.f / 256.f) + EPS);
            bf16_t* yo = WSP(bf16_t, WS_Y) + ((size_t)b * SEQ + t0 + tl) * DM;
#pragma unroll
            for (int j = 0; j < 4; ++j) yo[lane + 64 * j] = (bf16_t)f2bf(siluf_(v[j] * rstd * gg[j] + bb[j]));
        }
    }
    if (tt == 127) {
        float* oc = POUT + O_CP + (size_t)(l * 2 + b) * 30 * 256;
        for (int i = tid; i < 30 * 256; i += NTHR) oc[i] = bf2f(Us[64 * 256 + i]);
    }
}
__device__ __forceinline__ void conv_sample_item(const Args& A, const Ctx& C, int l, int b, LAS unsigned char* lds) {
    LAS float* Fs = (LAS float*)lds;
    LAS float* Ys = (LAS float*)(lds + 34816);
    int tid = C.tid, w = C.wave; asm volatile("" : "+v"(tid), "+s"(w)); const int lane = tid & 63;
    __syncthreads();
    const float* st = PIN(2) + (size_t)(l * DB + b) * 30 * 256;
    for (int i = tid; i < 30 * 256; i += NTHR) Fs[i] = st[i];
    for (int i = tid; i < 4 * 256; i += NTHR) Fs[30 * 256 + i] = bf2f(WSP(bf16_t, WS_ZB)[((size_t)MP + 4 * b + (i >> 8)) * ZW + (i & 255)]);
    __syncthreads();
    {
        const int c = tid & 255, half = tid >> 8;
        const float* Wl = PIN(12) + (size_t)l * 31 * 256;
        const float bias = PIN(13)[l * 256 + c];
        float a0 = bias, a1 = bias;
#pragma unroll
        for (int k = 0; k < 31; ++k) { const float wk = Wl[k * 256 + c]; a0 += wk * Fs[(2 * half + k) * 256 + c]; a1 += wk * Fs[(2 * half + 1 + k) * 256 + c]; }
        Ys[(2 * half) * 257 + c] = a0; Ys[(2 * half + 1) * 257 + c] = a1;
    }
    __syncthreads();
    if (w < 4) {
        const float* gl = PIN(14) + l * 256; const float* bl = PIN(15) + l * 256;
        float v[4]; float s = 0.f;
#pragma unroll
        for (int j = 0; j < 4; ++j) { v[j] = Ys[w * 257 + lane + 64 * j]; s += v[j]; }
        const float mean = wave_sum(s) * (1.f / 256.f); float q = 0.f;
#pragma unroll
        for (int j = 0; j < 4; ++j) { v[j] -= mean; q += v[j] * v[j]; }
        const float rstd = 1.0f / sqrtf(wave_sum(q) * (1.f / 256.f) + EPS);
        bf16_t* yo = WSP(bf16_t, WS_Y) + ((size_t)MP + 4 * b + w) * DM;
#pragma unroll
        for (int j = 0; j < 4; ++j) yo[lane + 64 * j] = (bf16_t)f2bf(siluf_(v[j] * rstd * gl[lane + 64 * j] + bl[lane + 64 * j]));
    }
    float* oc = POUT + O_CS + (size_t)(l * DB + b) * 30 * 256;
    for (int i = tid; i < 30 * 256; i += NTHR) oc[i] = Fs[4 * 256 + i];
}
__device__ __forceinline__ void attn_sample_item(const Args& A, const Ctx& C, int l, int item, LAS unsigned char* lds) {
    int tid = C.tid, w = C.wave; asm volatile("" : "+v"(tid), "+s"(w)); const int lane = tid & 63;
    const int pair = (w >= 3) ? ((w >= 6) ? 2 : 1) : 0, br = w - 3 * pair; const bool active = w < 6;
    const int idx = item * 2 + (active ? pair : 0); const int b = idx >> 4, t = (idx >> 2) & 3, h = idx & 3;
    LAS float* qs = (LAS float*)(lds + w * 1024);
    LAS float* ps = qs + 64;
    LAS float* res = (LAS float*)(lds + 8192);
    __syncthreads();
    const size_t srow = (size_t)MP + 4 * b + t;
    if (active) {
        qs[lane] = bf2f(WSP(bf16_t, WS_ZB)[srow * ZW + ZQ + h * 64 + lane]);
        LDS_FENCE();
        const float slope = exp2f(-2.f * (float)(h + 1));
        const float* ck = PIN(3) + (size_t)(l * DB + b) * 2048 * 256 + h * 64;
        const float* cv = PIN(4) + (size_t)(l * DB + b) * 2048 * 256 + h * 64;
        const int sh = 2 * br;
        float sc[3];
#pragma unroll
        for (int jj = 0; jj < 3; ++jj) {
            const int j = lane + 64 * jj; float sv = -1e30f;
            if (j <= 128) {
                const int ix = 2048 + t - (j << sh); float dot = 0.f;
                if (ix < 2048) { const f32x4* kp = (const f32x4*)(ck + (size_t)ix * 256);
#pragma unroll
                    for (int c4 = 0; c4 < 16; ++c4) { const f32x4 kv = kp[c4]; const f32x4 qv = *(const LAS f32x4*)(qs + 4 * c4); dot += (kv.x * qv.x + kv.y * qv.y) + (kv.z * qv.z + kv.w * qv.w); } }
                else { const bf16_t* kp = WSP(bf16_t, WS_ZB) + ((size_t)MP + 4 * b + (ix - 2048)) * ZW + ZK + h * 64;
#pragma unroll 8
                    for (int d = 0; d < 64; ++d) dot += bf2f(kp[d]) * qs[d]; }
                sv = dot - slope * (float)(j << sh);
            }
            sc[jj] = sv;
            if (jj == 1) asm volatile("" ::: "memory");
        }
        const float m = wave_max(fmaxf(fmaxf(sc[0], sc[1]), sc[2]));
        float lsum = 0.f;
#pragma unroll
        for (int jj = 0; jj < 3; ++jj) { const float p = __expf(sc[jj] - m); lsum += p; ps[lane + 64 * jj] = p; }
        lsum = wave_sum(lsum);
        LDS_FENCE();
        f32x4 o = (f32x4){0.f, 0.f, 0.f, 0.f};
        const int kg = lane >> 4, c4 = lane & 15;
#pragma unroll 11
        for (int j0 = 0; j0 < 132; j0 += 4) {
            const int j = j0 + kg;
            if (j <= 128) {
                const int ix = 2048 + t - (j << sh); f32x4 v;
                if (ix < 2048) v = *(const f32x4*)(cv + (size_t)ix * 256 + c4 * 4);
                else { const u32x2 r2 = *(const u32x2*)(WSP(bf16_t, WS_ZB) + ((size_t)MP + 4 * b + (ix - 2048)) * ZW + ZV + h * 64 + c4 * 4); v = (f32x4){bflo(r2.x), bfhi(r2.x), bflo(r2.y), bfhi(r2.y)}; }
                o += v * ps[j];
            }
        }
#pragma unroll
        for (int e = 0; e < 4; ++e) { o[e] += __shfl_xor(o[e], 16); o[e] += __shfl_xor(o[e], 32); }
        LAS float* rp = res + (pair * 3 + br) * 68;
        if (lane < 16) *(LAS f32x4*)(rp + 4 + lane * 4) = o;
        if (lane == 0) { rp[0] = m; rp[1] = lsum; }
    }
    __syncthreads();
    if (active && br == 0 && lane < 16) {
        const LAS float* r0 = res + (pair * 3) * 68; const LAS float* r1 = r0 + 68; const LAS float* r2 = r0 + 136;
        const float M = fmaxf(r0[0], fmaxf(r1[0], r2[0])); const float w0 = __expf(r0[0] - M), w1 = __expf(r1[0] - M), w2 = __expf(r2[0] - M);
        const float inv = 1.f / (r0[1] * w0 + r1[1] * w1 + r2[1] * w2);
        const f32x4 O = (*(const LAS f32x4*)(r0 + 4 + lane * 4) * w0 + *(const LAS f32x4*)(r1 + 4 + lane * 4) * w1 + *(const LAS f32x4*)(r2 + 4 + lane * 4) * w2) * inv;
        u32x2 wv; wv.x = pk2(O.x, O.y); wv.y = pk2(O.z, O.w);
        *(u32x2*)(WSP(bf16_t, WS_Y) + srow * DM + 256 + h * 64 + lane * 4) = wv;
    }
}
__device__ __forceinline__ void hgrn_sample_item(const Args& A, const Ctx& C, int l, int item, LAS unsigned char* lds) {
    const int b = item >> 2, h = item & 3; int tid = C.tid, w = C.wave; asm volatile("" : "+v"(tid), "+s"(w)); const int lane = tid & 63;
    LAS float* fs = (LAS float*)lds;
    LAS float* ks = fs + 512;
    LAS float* qq = ks + 512;
    LAS float* red = qq + 512;
    __syncthreads();
    { const int t = tid >> 7, d = tid & 127; const size_t row = (size_t)MP + 4 * b + t;
      fs[tid] = __expf(WSP(float, WS_LF)[row * 512 + h * 128 + d]); ks[tid] = bf2f(WSP(bf16_t, WS_ZB)[row * ZW + ZHK + h * 128 + d]); qq[tid] = bf2f(WSP(bf16_t, WS_ZB)[row * ZW + ZHQ + h * 128 + d]); }
    __syncthreads();
    const int v = tid & 127, dq = tid >> 7;
    const float* S0 = PIN(5) + (size_t)((l * DB + b) * 4 + h) * 16384;
    float S[32];
#pragma unroll
    for (int j = 0; j < 32; ++j) S[j] = S0[(dq * 32 + j) * 128 + v];
#pragma unroll
    for (int t = 0; t < 4; ++t) {
        const float vt = bf2f(WSP(bf16_t, WS_ZB)[((size_t)MP + 4 * b + t) * ZW + ZHV + h * 128 + v]);
        float op = 0.f;
#pragma unroll
        for (int j = 0; j < 32; ++j) { const int d = dq * 32 + j; S[j] = fs[t * 128 + d] * S[j] + ks[t * 128 + d] * vt; op += S[j] * qq[t * 128 + d]; }
        red[(t * 4 + dq) * 128 + v] = op;
    }
    float* So = POUT + O_HS + (size_t)((l * DB + b) * 4 + h) * 16384;
#pragma unroll
    for (int j = 0; j < 32; ++j) So[(dq * 32 + j) * 128 + v] = S[j];
    __syncthreads();
    if (w < 4) {
        const int t = w; const size_t row = (size_t)MP + 4 * b + t; const float* gn = PIN(17) + l * 128;
        float o[2]; float ss = 0.f;
#pragma unroll
        for (int j = 0; j < 2; ++j) { const int vv = lane + 64 * j; o[j] = red[(t * 4 + 0) * 128 + vv] + red[(t * 4 + 1) * 128 + vv] + red[(t * 4 + 2) * 128 + vv] + red[(t * 4 + 3) * 128 + vv]; ss += o[j] * o[j]; }
        const float rstd = 1.0f / sqrtf(wave_sum(ss) * (1.f / 128.f) + EPS);
#pragma unroll
        for (int j = 0; j < 2; ++j) { const int vv = lane + 64 * j; const float g = bf2f(WSP(bf16_t, WS_ZB)[row * ZW + ZHG + h * 128 + vv]);
            WSP(bf16_t, WS_Y)[row * DM + 512 + h * 128 + vv] = (bf16_t)f2bf(o[j] * rstd * gn[vv] * g); }
    }
}

#ifdef PROFILE_SIDE
#define MSTAMP(k) do { __syncthreads(); if (C.bid == 0 && C.tid == 0) { LAS unsigned* prof = (LAS unsigned*)(lds + 151040); const unsigned tn = (unsigned)__builtin_amdgcn_s_memrealtime(); prof[k] += tn - prof[15]; prof[15] = tn; } } while (0)
#else
#define MSTAMP(k) do {} while (0)
#endif
constexpr int NA_ATT = 1536, NA_H1 = 1024, NA_CONV = 256, NA_SATT = 256, NA_SCONV = 32, NA_SHG = 128;
constexpr int NA_TOTAL = NA_ATT + NA_H1 + NA_CONV + NA_SATT + NA_SCONV + NA_SHG;
__device__ __forceinline__ void mixerA_phase(const Args& A, const Ctx& C, int l, LAS unsigned char* lds) {
    int t0_ = C.tid; asm volatile("" : "+v"(t0_));
    { AttnRegs R = {}; int it = ((C.G & 7) == 0) ? (C.bid & 7) * (C.G >> 3) + (C.bid >> 3) : C.bid; if (it < NA_ATT) attn_load(A, it, t0_, R);
      for (; it < NA_ATT; it += C.G) attn_item(A, C, it, (it + C.G < NA_ATT) ? it + C.G : -1, R, lds); }
    { H1Regs R = {}; int it = C.bid; if (it < NA_H1) h1_load(A, it, t0_, R);
      for (; it < NA_H1; it += C.G) h1_item(A, C, it, (it + C.G < NA_H1) ? it + C.G : -1, R, lds); }
    for (int it = C.bid; it < NA_CONV; it += C.G) conv_item(A, C, l, it, lds);
    for (int it = C.bid; it < NA_SATT; it += C.G) attn_sample_item(A, C, l, it, lds);
    for (int it = C.bid; it < NA_SCONV; it += C.G) conv_sample_item(A, C, l, it, lds);
    for (int it = C.bid - NA_SCONV; it < NA_SHG; it += C.G) { if (it >= 0) hgrn_sample_item(A, C, l, it, lds); }
    __syncthreads();
}

__device__ __forceinline__ void mixerB_phase(const Args& A, const Ctx& C, int l) {
    int tid_ = C.tid; asm volatile("" : "+v"(tid_));
    const int gt = C.bid * NTHR + tid_, NGT = C.G * NTHR;
    for (int e = gt; e < 8 * 16384; e += NGT) {
        const int bh = e >> 14, vd = e & 16383, d = vd & 127, v = vd >> 7;
        float S = 0.f;
        const float* sl = WSP(float, WS_SL) + (size_t)bh * 128 * 16384 + vd; const float* dc = WSP(float, WS_DC) + (size_t)bh * 128 * 128 + d; bf16_t* sp = WSP(bf16_t, WS_SP) + (size_t)bh * 128 * 16384 + vd;
#pragma unroll 1
        for (int c0 = 0; c0 < 128; c0 += 32) {
            float slv[32], dcv[32];
#pragma unroll
            for (int k = 0; k < 32; ++k) { slv[k] = sl[(size_t)(c0 + k) * 16384]; dcv[k] = dc[(c0 + k) * 128]; }
#pragma unroll
            for (int k = 0; k < 32; ++k) { sp[(size_t)(c0 + k) * 16384] = (bf16_t)f2bf(S); S = dcv[k] * S + slv[k]; }
        }
        POUT[O_HP + (size_t)(l * 8 + bh) * 16384 + d * 128 + v] = S;
    }
    for (int i = gt; i < MP * 64; i += NGT) {
        const int row = i >> 6, c4 = i & 63, h = c4 >> 4;
        const float l0 = WSP(float, WS_LSE)[(size_t)row * 4 + h], l1 = WSP(float, WS_LSE)[(size_t)(MP + row) * 4 + h], l2 = WSP(float, WS_LSE)[(size_t)(2 * MP + row) * 4 + h];
        const float m = fmaxf(l0, fmaxf(l1, l2)); float w0 = __expf(l0 - m), w1 = __expf(l1 - m), w2 = __expf(l2 - m);
        const float inv = 1.f / (w0 + w1 + w2); w0 *= inv; w1 *= inv; w2 *= inv;
        const f32x4 a = *(const f32x4*)(WSP(float, WS_OP) + (size_t)row * 256 + c4 * 4), bq = *(const f32x4*)(WSP(float, WS_OP) + ((size_t)MP + row) * 256 + c4 * 4), cq = *(const f32x4*)(WSP(float, WS_OP) + ((size_t)2 * MP + row) * 256 + c4 * 4);
        const f32x4 y = a * w0 + bq * w1 + cq * w2;
        u32x2 wv; wv.x = pk2(y.x, y.y); wv.y = pk2(y.z, y.w);
        *(u32x2*)(WSP(bf16_t, WS_Y) + (size_t)row * DM + 256 + c4 * 4) = wv;
    }
}

constexpr int H3_QH = 34816, H3_KH = 52224, H3_QT = 69632, H3_VT = 87040, H3_ST = 105472, H3_P = 140288, H3_RED = 149504;
struct H3Regs { u32x4 q[2], k[2], v[2], s[4]; float lf[16]; };
__device__ __forceinline__ void h3_load(const Args& A, int item, int tid, H3Regs& R) {
    const int bh = item >> 7, c = item & 127, b = bh >> 2, h = bh & 3; const size_t row0 = (size_t)b * SEQ + c * 64;
#pragma unroll
    for (int a = 0; a < 2; ++a) { const int i = tid + a * NTHR; const int s = i >> 4, ch = i & 15, d0 = ch * 8;
        const bf16_t* p = WSP(bf16_t, WS_ZB) + (row0 + s) * ZW + h * 128 + d0; R.q[a] = *(const u32x4*)(p + ZHQ); R.k[a] = *(const u32x4*)(p + ZHK); R.v[a] = *(const u32x4*)(p + ZHV); }
    { const bf16_t* sp = WSP(bf16_t, WS_SP) + (size_t)item * 16384;
#pragma unroll
      for (int a = 0; a < 4; ++a) { const int i = tid + a * NTHR; const int v = i >> 4, ch = i & 15; R.s[a] = *(const u32x4*)(sp + v * 128 + ch * 8); } }
    { const float* src = WSP(float, WS_LF) + row0 * 512 + h * 128; const int d = tid & 127, part = tid >> 7;
#pragma unroll
      for (int s = 0; s < 16; ++s) R.lf[s] = src[(size_t)(part * 16 + s) * 512 + d]; }
}
__device__ __forceinline__ void h3_item(const Args& A, const Ctx& C, int l, int item, int next_item, H3Regs& R, LAS unsigned char* lds) {
    const int bh = item >> 7, c = item & 127, b = bh >> 2, h = bh & 3; const size_t row0 = (size_t)b * SEQ + c * 64;
    LAS float* Bc = (LAS float*)(lds + H_BC); LAS float* Tot = (LAS float*)(lds + H_TOT);
    LAS bf16_t* Qh = (LAS bf16_t*)(lds + H3_QH); LAS bf16_t* Kh = (LAS bf16_t*)(lds + H3_KH); LAS bf16_t* Qt = (LAS bf16_t*)(lds + H3_QT);
    LAS bf16_t* VT = (LAS bf16_t*)(lds + H3_VT);
    LAS bf16_t* ST = (LAS bf16_t*)(lds + H3_ST);
    LAS bf16_t* P = (LAS bf16_t*)(lds + H3_P);
    LAS float* red = (LAS float*)(lds + H3_RED);
    int tid = C.tid, w = C.wave; asm volatile("" : "+v"(tid), "+s"(w)); const int lane = tid & 63, fr = lane & 15, fq = lane >> 4;
    __syncthreads();
    chunk_cumsum_regs(R.lf, Bc, Tot, tid);
#pragma unroll
    for (int a = 0; a < 2; ++a) { const int i = tid + a * NTHR; const int s = i >> 4, ch = i & 15, d0 = ch * 8;
        const u32x4 qv = R.q[a], kk = R.k[a], vv = R.v[a];
        const unsigned qw[4] = {qv.x, qv.y, qv.z, qv.w}, kw[4] = {kk.x, kk.y, kk.z, kk.w}, vw[4] = {vv.x, vv.y, vv.z, vv.w};
        float qh[8], kh[8], qt[8];
#pragma unroll
        for (int e = 0; e < 8; ++e) { const int d = d0 + e; const float qf = (e & 1) ? bfhi(qw[e >> 1]) : bflo(qw[e >> 1]); const float kf = (e & 1) ? bfhi(kw[e >> 1]) : bflo(kw[e >> 1]);
            const float bt = Bc[s * 128 + d], bm = Bc[31 * 128 + d];
            qh[e] = qf * __expf(bt - bm); kh[e] = kf * __expf(bm - bt); qt[e] = qf * __expf(bt);
            VT[d * 72 + s] = (bf16_t)((e & 1) ? (vw[e >> 1] >> 16) : (vw[e >> 1] & 0xffffu)); }
        u32x4 o;
        o.x = pk2(qh[0], qh[1]); o.y = pk2(qh[2], qh[3]); o.z = pk2(qh[4], qh[5]); o.w = pk2(qh[6], qh[7]); *(LAS u32x4*)(Qh + s * 136 + d0) = o;
        o.x = pk2(kh[0], kh[1]); o.y = pk2(kh[2], kh[3]); o.z = pk2(kh[4], kh[5]); o.w = pk2(kh[6], kh[7]); *(LAS u32x4*)(Kh + s * 136 + d0) = o;
        o.x = pk2(qt[0], qt[1]); o.y = pk2(qt[2], qt[3]); o.z = pk2(qt[4], qt[5]); o.w = pk2(qt[6], qt[7]); *(LAS u32x4*)(Qt + s * 136 + d0) = o; }
#pragma unroll
    for (int a = 0; a < 4; ++a) { const int i = tid + a * NTHR; const int v = i >> 4, ch = i & 15; *(LAS u32x4*)(ST + v * 136 + ch * 8) = R.s[a]; }
    __syncthreads();
    const int ti = w >> 1;
    unsigned short gst[4][4];
#pragma unroll
    for (int i = 0; i < 4; ++i)
#pragma unroll
        for (int j = 0; j < 4; ++j) gst[i][j] = WSP(bf16_t, WS_ZB)[(row0 + 16 * ti + 4 * fq + i) * ZW + ZHG + h * 128 + 16 * (4 * (w & 1) + j) + fr];
    if (next_item >= 0) h3_load(A, next_item, tid, R);
    {
        const int si0 = 2 * (w & 1);
#pragma unroll
        for (int sj = 0; sj < 2; ++sj) { const int si = si0 + sj; f32x4 a = (f32x4){0.f, 0.f, 0.f, 0.f};
#pragma unroll
            for (int k = 0; k < 4; ++k) { const bf16x8 fa = ldfrag(Qh, 136, 16 * ti, 32 * k, lane), fb = ldfrag(Kh, 136, 16 * si, 32 * k, lane); a = MFMA16(fa, fb, a); }
#pragma unroll
            for (int i = 0; i < 4; ++i) { const int t = 16 * ti + 4 * fq + i, s = 16 * si + fr; const float pv = (s <= t) ? a[i] : 0.f; P[t * 72 + s] = (bf16_t)f2bf(pv); } }
    }
    __syncthreads();
    f32x4 acc[4];
    const int vt0 = 4 * (w & 1);
#pragma unroll
    for (int j = 0; j < 4; ++j) acc[j] = (f32x4){0.f, 0.f, 0.f, 0.f};
#pragma unroll
    for (int k = 0; k < 2; ++k) { const bf16x8 fa = ldfrag(P, 72, 16 * ti, 32 * k, lane);
#pragma unroll
        for (int j = 0; j < 4; ++j) { const bf16x8 fb = ldfrag(VT, 72, 16 * (vt0 + j), 32 * k, lane); acc[j] = MFMA16(fa, fb, acc[j]); } }
#pragma unroll
    for (int k = 0; k < 4; ++k) { const bf16x8 fa = ldfrag(Qt, 136, 16 * ti, 32 * k, lane);
#pragma unroll
        for (int j = 0; j < 4; ++j) { const bf16x8 fb = ldfrag(ST, 136, 16 * (vt0 + j), 32 * k, lane); acc[j] = MFMA16(fa, fb, acc[j]); } }
    float ss[4];
#pragma unroll
    for (int i = 0; i < 4; ++i) { float q = 0.f;
#pragma unroll
        for (int j = 0; j < 4; ++j) q += acc[j][i] * acc[j][i];
        ss[i] = sum16(q); }
    if (fr == 0) {
#pragma unroll
        for (int i = 0; i < 4; ++i) red[(w & 1) * 64 + 16 * ti + 4 * fq + i] = ss[i];
    }
    __syncthreads();
    const float* gn = PIN(17) + l * 128;
#pragma unroll
    for (int i = 0; i < 4; ++i) { const int t = 16 * ti + 4 * fq + i; const float rstd = 1.0f / sqrtf((red[t] + red[64 + t]) * (1.f / 128.f) + EPS);
        const size_t row = row0 + t;
#pragma unroll
        for (int j = 0; j < 4; ++j) { const int v = 16 * (vt0 + j) + fr; const float g = bf2f(gst[i][j]);
            WSP(bf16_t, WS_Y)[row * DM + 512 + h * 128 + v] = (bf16_t)f2bf(acc[j][i] * rstd * gn[v] * g); } }
}

#define XB_TMO      128
#define XB_XCNT(j)  (256  + 64 * (j))
#define XB_XSUB(j)  (1280 + 64 * (j))
#define XB_XGEN(j)  (2304 + 64 * (j))
#define XB_TOP      3328
#define XB_TOPGEN   3392
#define XCD_BAR_WORDS 3456
#define XB_SPIN_CAP (1u << 18)

__device__ __forceinline__ unsigned xb_ld(unsigned* p)              { return __hip_atomic_load(p, __ATOMIC_RELAXED, __HIP_MEMORY_SCOPE_AGENT); }
__device__ __forceinline__ unsigned xb_add(unsigned* p, unsigned v) { return __hip_atomic_fetch_add(p, v, __ATOMIC_RELAXED, __HIP_MEMORY_SCOPE_AGENT); }
__device__ __forceinline__ unsigned xb_xcc_id() { return (unsigned)__builtin_amdgcn_s_getreg((3 << 11) | 20) & 0xFu; }
#define XB_SPIN(cond, bar) do { unsigned _sp = 0; while (cond) { __builtin_amdgcn_s_sleep(1); \
    if ((++_sp & 255u) == 0u) { if (xb_ld(&(bar)[XB_TMO])) break; if (_sp > XB_SPIN_CAP) { atomicAdd(&(bar)[XB_TMO], 1u); break; } } } } while (0)

struct XcdBarrier {
    unsigned* bar; unsigned x;
    volatile LAS unsigned* st;
};

__device__ __forceinline__ XcdBarrier xcd_barrier_post(unsigned* bar, volatile LAS unsigned* st) {
    XcdBarrier b; b.bar = bar; b.x = xb_xcc_id(); b.st = st;
    if (threadIdx.x == 0) (void)xb_add(&bar[XB_XCNT(b.x)], 1u);
    return b;
}
__device__ __forceinline__ void xcd_barrier_complete(unsigned* bar, unsigned x, unsigned& nloc, unsigned& nx) {
    const unsigned G = gridDim.x * gridDim.y * gridDim.z;
    unsigned sum, cnt, mine, sp = 0u;
    for (;;) {
        sum = 0u; cnt = 0u; mine = 0u;
#pragma unroll
        for (unsigned j = 0; j < 16; ++j) { const unsigned c = xb_ld(&bar[XB_XCNT(j)]); sum += c; cnt += (c > 0u) ? 1u : 0u; mine = (j == x) ? c : mine; }
        if (sum == G) break;
        __builtin_amdgcn_s_sleep(1);
        if ((++sp & 255u) == 0u) { if (xb_ld(&bar[XB_TMO])) break; if (sp > XB_SPIN_CAP) { atomicAdd(&bar[XB_TMO], 1u); break; } }
    }
    nloc = mine > 0u ? mine : 1u; nx = cnt > 0u ? cnt : 1u;
}

__device__ __forceinline__ void xcd_barrier(const XcdBarrier& b) {
    asm volatile("s_waitcnt vmcnt(0)" ::: "memory");
    __syncthreads();
    unsigned tx_ = threadIdx.x; asm volatile("" : "+v"(tx_));
    if (tx_ == 0) {
        unsigned* bar = b.bar; unsigned bx_ = b.x; asm volatile("" : "+s"(bar), "+s"(bx_));
        __builtin_amdgcn_s_waitcnt(0);
        unsigned nloc = b.st[0], nx = b.st[1];
        if (nloc == 0u) { xcd_barrier_complete(bar, bx_, nloc, nx); b.st[0] = nloc; b.st[1] = nx; }
        const unsigned old = xb_add(&bar[XB_XSUB(bx_)], 1u);
        const unsigned gen = old / nloc;
        if (old + 1u == (gen + 1u) * nloc) {
            __builtin_amdgcn_fence(__ATOMIC_RELEASE, "agent");
            asm volatile("s_waitcnt vmcnt(0)" ::: "memory");
            const unsigned og = xb_add(&bar[XB_TOP], 1u);
            const unsigned tg = og / nx;
            if (og + 1u == (tg + 1u) * nx) xb_add(&bar[XB_TOPGEN], 1u);
            else XB_SPIN(xb_ld(&bar[XB_TOPGEN]) == tg, bar);
            __builtin_amdgcn_fence(__ATOMIC_ACQUIRE, "agent");
            xb_add(&bar[XB_XGEN(bx_)], 1u);
            asm volatile("s_waitcnt vmcnt(0)" ::: "memory");
        } else {
            XB_SPIN(xb_ld(&bar[XB_XGEN(bx_)]) == gen, bar);
            __builtin_amdgcn_fence(__ATOMIC_ACQUIRE, "agent");
            asm volatile("s_waitcnt vmcnt(0)" ::: "memory");
        }
    }
    __syncthreads();
}

__global__ void __launch_bounds__(NTHR, 2) fwd_megakernel(Args args) {
    cg::grid_group grid = cg::this_grid();
    LAS unsigned char* lds = (LAS unsigned char*)lds_raw;
    const Args& A = args;
    if (threadIdx.x < 26) ((LAS unsigned long long*)((LAS unsigned char*)lds_raw + PT_OFF))[threadIdx.x] = ((const unsigned long long*)&args)[threadIdx.x];
    if (threadIdx.x >= 32 && threadIdx.x < 36) ((LAS unsigned*)((LAS unsigned char*)lds_raw + PT_OFF + 256))[threadIdx.x - 32] = 0u;
    __syncthreads();
    XcdBarrier xbar = xcd_barrier_post((unsigned*)(args.ws + WS_BAR), (volatile LAS unsigned*)((LAS unsigned char*)lds_raw + PT_OFF + 256));
    Ctx C;
    C.tid = threadIdx.x; C.wave = __builtin_amdgcn_readfirstlane(C.tid >> 6); C.G = gridDim.x; C.bid = blockIdx.x;

#ifndef NO_PRO
    prologue_phase(A, C, lds);
#endif
    if (args.ws == nullptr) grid.sync();
    xcd_barrier(xbar);
#ifdef PROFILE_SIDE
    LAS unsigned* prof = (LAS unsigned*)(lds + 151040);
    if (C.bid == 0 && C.tid == 0) { for (int k = 0; k < 16; ++k) prof[k] = 0; prof[15] = (unsigned)__builtin_amdgcn_s_memrealtime(); prof[14] = prof[15]; }
#define PSTAMP(k) do { if (C.bid == 0 && C.tid == 0) { const unsigned tn = (unsigned)__builtin_amdgcn_s_memrealtime(); prof[k] += tn - prof[15]; prof[15] = tn; } } while (0)
#else
#define PSTAMP(k) do {} while (0)
#endif
#pragma unroll 1
    for (int l = 0; l < DEPTH; ++l) {
#pragma unroll 1
        for (int f = 0; f < 2; ++f) {
            if (f == 1) {
                norm_phase<0>(A, C, PIN(10) + l * DM, 11);
                xcd_barrier(xbar); PSTAMP(1);
                {
                    pg8::Gemm g{WSP(bf16_t, WS_XN), (const bf16_t*)(PWS + WS_WIN + (size_t)l * SZ_WIN), MPAD, NIN, DM}; pg8::StaticOrder S; S.init(MPAD, NIN, C.G, C.bid, DM);
                    EpiWin E{WSP(bf16_t, WS_ZB), WSP(float, WS_LF), WSP(float, WS_LB) + l * 512, POUT + O_KP + (size_t)l * 2 * 2048 * 256, POUT + O_VP + (size_t)l * 2 * 2048 * 256,
                             POUT + O_KS + (size_t)l * MS * 256, POUT + O_VS + (size_t)l * MS * 256};

#ifndef NO_GWIN
 pg8::gemm_phase<EpiWin, pg8::StaticOrder, true, true>(lds, g, S, E);
#endif

                }
                xcd_barrier(xbar); PSTAMP(4);
#ifndef NO_MA
                mixerA_phase(A, C, l, lds);
#endif
                xcd_barrier(xbar); PSTAMP(5);
#ifndef NO_MB
                mixerB_phase(A, C, l);
#endif
                xcd_barrier(xbar); PSTAMP(6);
#ifndef NO_MC
                { H3Regs R = {}; int it = C.bid; int t0_ = C.tid; asm volatile("" : "+v"(t0_)); if (it < 1024) h3_load(A, it, t0_, R);
                  for (; it < 1024; it += C.G) h3_item(A, C, l, it, (it + C.G < 1024) ? it + C.G : -1, R, lds); }
#endif
                __syncthreads();
                xcd_barrier(xbar); PSTAMP(7);
                {
                    pg8::Gemm g{WSP(bf16_t, WS_Y), (const bf16_t*)(PWS + WS_WO + (size_t)l * SZ_WO), MPAD, DM, DM}; pg8::SplitOrder S; S.init(MP, DM, C.G, C.bid, DM, 4);
                    EpiResid E{WSP(float, WS_X), WSP(float, WS_SL)};

#ifndef NO_GRES
 pg8::gemm_phase<EpiResid, pg8::SplitOrder, false, true>(lds, g, S, E);
#endif

                }
                xcd_barrier(xbar); PSTAMP(8);
                norm_phase<0>(A, C, PIN(19) + l * DM, 4);
                xcd_barrier(xbar); PSTAMP(1);
            }
            {
                pg8::Gemm g{WSP(bf16_t, WS_XN), (const bf16_t*)(PWS + WS_WGU + (size_t)(l * 2 + f) * SZ_WGU), MPAD, 2 * FF, DM}; pg8::StaticOrder S; S.init(MPAD, 2 * FF, C.G, C.bid, DM);
                EpiSwiglu E{WSP(bf16_t, WS_ACT)};

#ifndef NO_GSW
 pg8::gemm_phase<EpiSwiglu, pg8::StaticOrder, true, true>(lds, g, S, E);
#endif

            }
            xcd_barrier(xbar); PSTAMP(2);
            {
                pg8::Gemm g{WSP(bf16_t, WS_ACT), (const bf16_t*)(PWS + WS_WD + (size_t)(l * 2 + f) * SZ_WD), MPAD, DM, FF}; pg8::SplitOrder S; S.init(MP, DM, C.G, C.bid, FF, 11);
                EpiResid E{WSP(float, WS_X), WSP(float, WS_SL)};

#ifndef NO_GRES
 pg8::gemm_phase<EpiResid, pg8::SplitOrder, false, true>(lds, g, S, E);
#endif

            }
            xcd_barrier(xbar); PSTAMP(3);
        }
        if (l + 1 < DEPTH) { norm_phase<0>(A, C, PIN(6) + (l + 1) * DM, 11); xcd_barrier(xbar); PSTAMP(1); }
    }
    norm_phase<2>(A, C, PIN(23), 11);
#ifdef PROFILE_SIDE
    xcd_barrier(xbar); PSTAMP(1);
    for (int q = 0; q < 16; ++q) xcd_barrier(xbar);
    PSTAMP(12);
    if (C.bid == 0 && C.tid == 0) {
        prof[9] = prof[15] - prof[14];
#pragma unroll 1
        for (int k = 1; k < 10; ++k) { const unsigned n = prof[k] / 100u;
            const size_t off = (k == 1) ? O_YS : (k == 2) ? O_CP : (k == 3) ? O_CS : (k == 4) ? O_KP : (k == 5) ? O_VP : (k == 6) ? O_KS : (k == 7) ? O_VS : (k == 8) ? O_HP : O_HS;
            for (unsigned i = 0; i < n && i < 60000u; ++i) ((unsigned*)POUT)[off + i] = 0xAAAAAAAAu; }
    }
#endif
}

extern "C" void kernel_launch(void* const* d_in, const int* in_sizes, int n_in, void* d_out, int out_size, void* d_ws, size_t ws_size, hipStream_t stream) {
    static int grid = 0;
    if (grid == 0) {
        if (n_in != 24 || (size_t)out_size != O_END || ws_size < WS_END) { fprintf(stderr, "kernel_launch: unexpected shapes: n_in %d out %d ws %zu (need %zu)\n", n_in, out_size, ws_size, (size_t)WS_END); grid = -1; return; }
        int dev = 0, cus = 0, per_cu = 0;
        hipGetDevice(&dev);
        hipDeviceGetAttribute(&cus, hipDeviceAttributeMultiprocessorCount, dev);
        if (hipFuncSetAttribute((const void*)fwd_megakernel, hipFuncAttributeMaxDynamicSharedMemorySize, LDS_BYTES) != hipSuccess) { fprintf(stderr, "kernel_launch: hipFuncSetAttribute failed\n"); grid = -1; return; }
        hipOccupancyMaxActiveBlocksPerMultiprocessor(&per_cu, (const void*)fwd_megakernel, NTHR, LDS_BYTES);
        if (per_cu < 1) { fprintf(stderr, "kernel_launch: occupancy query says %d blocks/CU\n", per_cu); per_cu = 1; }
        (void)hipGetLastError();
        grid = cus;
    }
    if (grid < 0) return;
    Args a{};
    for (int i = 0; i < 24; ++i) a.in[i] = (const float*)d_in[i];
    a.out = (float*)d_out; a.ws = (unsigned char*)d_ws;
    (void)hipMemsetAsync((unsigned char*)d_ws + WS_BAR, 0, WS_BAR_BYTES, stream);
    void* kargs[] = {&a};
    hipError_t e = hipLaunchCooperativeKernel((const void*)fwd_megakernel, dim3(grid), dim3(NTHR), kargs, LDS_BYTES, stream);
    if (e != hipSuccess) fprintf(stderr, "cooperative launch failed: %s (grid %d)\n", hipGetErrorString(e), grid);
}
```
